# Optimizing an MI355X kernel written in HIP

```python
import jax, jax.numpy as jnp
from jax import lax
import numpy as np

D_MODEL = 4096
BATCH = 1
SEQ = 8192
DEPTH = 1
DEC_BATCH = 128
DEC_SEQ = 4
PAST_LEN = 8192
PAGE_SIZE = 128

N_META = 16
ATTN_WIDTH = D_MODEL // 2
CONV_WIDTH = D_MODEL - ATTN_WIDTH
HEAD_DIM = 64
N_HEADS = ATTN_WIDTH // HEAD_DIM
N_KV_HEADS = N_HEADS // 8
GROUP = N_HEADS // N_KV_HEADS
ROPE_DIM = HEAD_DIM // 4
ROPE_THETA = 500000.0
WINDOW = 128
BLOCK = 128
CONV_K = 3
D_FF = ((8 * D_MODEL // 3 + 255) // 256) * 256
EPS = 1e-5
Q_W = N_HEADS * HEAD_DIM
KV_W = N_KV_HEADS * HEAD_DIM
IN_W = Q_W + 2 * KV_W + 3 * CONV_WIDTH
NEG = -1e30

kernel_name = "hybrid_swa_sink_shortconv_convffn_step"


def rmsnorm(x, g):
    xf = x.astype(jnp.float32)
    y = xf * lax.rsqrt(jnp.mean(xf * xf, axis=-1, keepdims=True) + EPS) * g.astype(jnp.float32)
    return y.astype(x.dtype)


def rope(x, pos):
    half = ROPE_DIM // 2
    inv = ROPE_THETA ** (-jnp.arange(half, dtype=jnp.float32) * 2.0 / ROPE_DIM)
    ang = pos.astype(jnp.float32)[:, None] * inv
    cos = jnp.cos(ang)[:, None, :]
    sin = jnp.sin(ang)[:, None, :]
    x1 = x[..., :half].astype(jnp.float32)
    x2 = x[..., half:ROPE_DIM].astype(jnp.float32)
    r1 = (x1 * cos - x2 * sin).astype(x.dtype)
    r2 = (x2 * cos + x1 * sin).astype(x.dtype)
    return jnp.concatenate([r1, r2, x[..., ROPE_DIM:]], axis=-1)


def sink_attend(q, k, v, mask, sinks):
    s = jnp.einsum('...qkgd,...skd->...kgqs', q.astype(jnp.float32), k.astype(jnp.float32)) * (HEAD_DIM ** -0.5)
    s = jnp.where(mask, s, NEG)
    sink = sinks.astype(jnp.float32).reshape(N_KV_HEADS, GROUP)[:, :, None, None]
    m = jnp.maximum(jnp.max(s, axis=-1, keepdims=True), sink)
    p = jnp.exp(s - m)
    p = p / (jnp.sum(p, axis=-1, keepdims=True) + jnp.exp(sink - m))
    o = jnp.einsum('...kgqs,...skd->...qkgd', p, v.astype(jnp.float32))
    return o.astype(q.dtype)


def attn_prompt(q, k, v, sinks):
    B, L = q.shape[0], q.shape[1]
    pad = (-N_META) % BLOCK
    Lp = L + pad
    nb = Lp // BLOCK
    qb = jnp.pad(q, ((0, 0), (pad, 0), (0, 0), (0, 0))).reshape(B, nb, BLOCK, N_KV_HEADS, GROUP, HEAD_DIM)
    kc = jnp.pad(k, ((0, 0), (pad, 0), (0, 0), (0, 0))).reshape(B, nb, BLOCK, N_KV_HEADS, HEAD_DIM)
    vc = jnp.pad(v, ((0, 0), (pad, 0), (0, 0), (0, 0))).reshape(B, nb, BLOCK, N_KV_HEADS, HEAD_DIM)
    bpad = ((0, 0), (1, 0), (0, 0), (0, 0), (0, 0))
    kb = jnp.concatenate([jnp.pad(kc, bpad)[:, :-1], kc], axis=2)
    vb = jnp.concatenate([jnp.pad(vc, bpad)[:, :-1], vc], axis=2)
    qpos = (jnp.arange(Lp) - pad).reshape(nb, BLOCK)
    kpos = jnp.concatenate([qpos - BLOCK, qpos], axis=1)
    qq = qpos[:, :, None]
    kk = kpos[:, None, :]
    mask = (kk >= 0) & (kk <= qq) & (kk > qq - WINDOW)
    o = sink_attend(qb, kb, vb, mask[None, :, None, None], sinks)
    o = o.reshape(B, Lp, Q_W)[:, pad:]
    return o, k[:, -WINDOW:], v[:, -WINDOW:]


def attn_sample(q, k, v, sinks, cache_k, cache_v):
    DB, T = q.shape[0], q.shape[1]
    W = cache_k.shape[1]
    kk_all = jnp.concatenate([cache_k.astype(k.dtype), k], axis=1)
    vv_all = jnp.concatenate([cache_v.astype(v.dtype), v], axis=1)
    kpos = jnp.arange(W + T) + (PAST_LEN - W)
    qpos = jnp.arange(T) + PAST_LEN
    qq = qpos[:, None]
    kk = kpos[None, :]
    mask = (kk <= qq) & (kk > qq - WINDOW)
    o = sink_attend(q.reshape(DB, T, N_KV_HEADS, GROUP, HEAD_DIM), kk_all, vv_all, mask, sinks)
    return o.reshape(DB, T, Q_W), kk_all[:, -W:], vv_all[:, -W:]


def causal_dwconv(u, w, prev):
    T = u.shape[1]
    up = jnp.concatenate([prev.astype(u.dtype), u], axis=1)
    y = up[:, 0:T] * w[0]
    for i in range(1, CONV_K):
        y = y + up[:, i:i + T] * w[i]
    return y, up[:, -(CONV_K - 1):]


def layer(h, pos, attn_fn, conv_prev, ffn_prev, g_mix, w_in, sinks, conv_w, g_attn_out,
          g_conv_out, w_out, g_ffn, w_gate_up, ffn_conv_w, w_down):
    B, T = h.shape[0], h.shape[1]
    a = rmsnorm(h, g_mix)
    proj = a @ w_in
    splits = [Q_W, Q_W + KV_W, Q_W + 2 * KV_W, Q_W + 2 * KV_W + CONV_WIDTH, Q_W + 2 * KV_W + 2 * CONV_WIDTH]
    q, k, v, cb, cc, cx = jnp.split(proj, splits, axis=-1)
    q = rope(q.reshape(B, T, N_HEADS, HEAD_DIM), pos)
    k = rope(k.reshape(B, T, N_KV_HEADS, HEAD_DIM), pos)
    v = v.reshape(B, T, N_KV_HEADS, HEAD_DIM)
    attn_o, new_k, new_v = attn_fn(q, k, v, sinks)
    conv_y, new_conv = causal_dwconv(cc * cx, conv_w, conv_prev)
    conv_o = cb * conv_y
    mixed = jnp.concatenate([rmsnorm(attn_o, g_attn_out), rmsnorm(conv_o, g_conv_out)], axis=-1) @ w_out
    h = h + mixed
    f = rmsnorm(h, g_ffn)
    gate, up = jnp.split(f @ w_gate_up, [D_FF], axis=-1)
    gate_c, new_ffn = causal_dwconv(gate, ffn_conv_w, ffn_prev)
    h = h + (jax.nn.silu(gate_c) * up) @ w_down
    return h, new_k, new_v, new_conv, new_ffn


def setup_inputs(seed: int = 0) -> dict:
    key = jax.random.key(seed)
    ks = jax.random.split(key, 24)
    f32 = jnp.float32
    nrm = lambda k, shape, s: jax.random.normal(k, shape, f32) * s
    gain = lambda k, shape: 1.0 + 0.02 * jax.random.normal(k, shape, f32)
    return {
        "x_prompt": nrm(ks[0], (BATCH, SEQ, D_MODEL), 1.0),
        "x_sample": nrm(ks[1], (DEC_BATCH, DEC_SEQ, D_MODEL), 1.0),
        "cache_k": nrm(ks[2], (DEPTH, DEC_BATCH, WINDOW, N_KV_HEADS, HEAD_DIM), 1.0),
        "cache_v": nrm(ks[3], (DEPTH, DEC_BATCH, WINDOW, N_KV_HEADS, HEAD_DIM), 1.0),
        "state_conv": nrm(ks[4], (DEPTH, DEC_BATCH, CONV_K - 1, CONV_WIDTH), 1.0),
        "state_ffn_conv": nrm(ks[5], (DEPTH, DEC_BATCH, CONV_K - 1, D_FF), 1.0),
        "meta_tokens": nrm(ks[6], (N_META, D_MODEL), 1.0),
        "g_mix": gain(ks[7], (DEPTH, D_MODEL)),
        "w_in": nrm(ks[8], (DEPTH, D_MODEL, IN_W), D_MODEL ** -0.5),
        "attn_sinks": nrm(ks[9], (DEPTH, N_HEADS), 0.5),
        "conv_w": nrm(ks[10], (DEPTH, CONV_K, CONV_WIDTH), CONV_K ** -0.5),
        "g_attn_out": gain(ks[11], (DEPTH, ATTN_WIDTH)),
        "g_conv_out": gain(ks[12], (DEPTH, CONV_WIDTH)),
        "w_out": nrm(ks[13], (DEPTH, D_MODEL, D_MODEL), D_MODEL ** -0.5),
        "g_ffn": gain(ks[14], (DEPTH, D_MODEL)),
        "w_gate_up": nrm(ks[15], (DEPTH, D_MODEL, 2 * D_FF), D_MODEL ** -0.5),
        "ffn_conv_w": nrm(ks[16], (DEPTH, CONV_K, D_FF), CONV_K ** -0.5),
        "w_down": nrm(ks[17], (DEPTH, D_FF, D_MODEL), D_FF ** -0.5),
        "g_final": gain(ks[18], (D_MODEL,)),
    }


def reference(x_prompt, x_sample, cache_k, cache_v, state_conv, state_ffn_conv, meta_tokens,
              g_mix, w_in, attn_sinks, conv_w, g_attn_out, g_conv_out, w_out, g_ffn,
              w_gate_up, ffn_conv_w, w_down, g_final):
    B = x_prompt.shape[0]
    DB, T = x_sample.shape[0], x_sample.shape[1]
    meta = jnp.broadcast_to(meta_tokens.astype(x_prompt.dtype)[None], (B, N_META, D_MODEL))
    hp = jnp.concatenate([meta, x_prompt], axis=1)
    hs = x_sample
    pos_p = jnp.arange(hp.shape[1])
    pos_s = jnp.arange(T) + PAST_LEN
    nk_p, nv_p, nc_p, nf_p = [], [], [], []
    nk_s, nv_s, nc_s, nf_s = [], [], [], []
    for l in range(DEPTH):
        w = (g_mix[l], w_in[l], attn_sinks[l], conv_w[l], g_attn_out[l], g_conv_out[l], w_out[l],
             g_ffn[l], w_gate_up[l], ffn_conv_w[l], w_down[l])
        zc = jnp.zeros((B, CONV_K - 1, CONV_WIDTH), hp.dtype)
        zf = jnp.zeros((B, CONV_K - 1, D_FF), hp.dtype)
        hp, k1, v1, c1, f1 = layer(hp, pos_p, attn_prompt, zc, zf, *w)
        ck, cv = cache_k[l], cache_v[l]
        samp_fn = lambda q, k, v, s, ck=ck, cv=cv: attn_sample(q, k, v, s, ck, cv)
        hs, k2, v2, c2, f2 = layer(hs, pos_s, samp_fn, state_conv[l], state_ffn_conv[l], *w)
        nk_p.append(k1); nv_p.append(v1); nc_p.append(c1); nf_p.append(f1)
        nk_s.append(k2); nv_s.append(v2); nc_s.append(c2); nf_s.append(f2)
    y_prompt = rmsnorm(hp[:, N_META:], g_final)
    y_sample = rmsnorm(hs, g_final)
    return (y_prompt, y_sample,
            jnp.stack(nk_p), jnp.stack(nv_p), jnp.stack(nc_p), jnp.stack(nf_p),
            jnp.stack(nk_s), jnp.stack(nv_s), jnp.stack(nc_s), jnp.stack(nf_s))
```

```cpp
#include <hip/hip_runtime.h>
#include <hip/hip_cooperative_groups.h>
#include <cstdio>
namespace cg = cooperative_groups;

#define LAS __attribute__((address_space(3)))
typedef unsigned short bf16_t;
typedef short bf16x8 __attribute__((ext_vector_type(8)));
typedef float f32x4 __attribute__((ext_vector_type(4)));
typedef float f32x2 __attribute__((ext_vector_type(2)));
typedef unsigned u32x4 __attribute__((ext_vector_type(4)));
typedef unsigned u32x2 __attribute__((ext_vector_type(2)));

constexpr int DM = 4096, LP = 8208  , NSR = 512  , MR = LP + NSR  , MPAD = 8960  ;
constexpr int QW = 2048, CWID = 2048, INW = 8704, DFF = 11008;
constexpr float EPS = 1e-5f;
constexpr size_t OFF_YP = 0, OFF_YS = OFF_YP + (size_t)8192 * 4096, OFF_NKP = OFF_YS + (size_t)512 * 4096, OFF_NVP = OFF_NKP + 32768, OFF_NCP = OFF_NVP + 32768,
                 OFF_NFP = OFF_NCP + 4096, OFF_NKS = OFF_NFP + 22016, OFF_NVS = OFF_NKS + 4194304, OFF_NCS = OFF_NVS + 4194304, OFF_NFS = OFF_NCS + 524288,
                 OUT_TOTAL = OFF_NFS + 2818048;
constexpr size_t WS_W1 = 0, WS_W2 = WS_W1 + (size_t)INW * DM * 2, WS_W3 = WS_W2 + (size_t)DM * DM * 2, WS_W4 = WS_W3 + (size_t)2 * DFF * DM * 2,
                 WS_SM = WS_W4 + (size_t)DM * DFF * 2, WS_KP = WS_SM + (1u << 20), WS_KS = WS_KP + (size_t)LP * 256 * 2, WS_VTP = WS_KS + (size_t)128 * 132 * 256 * 2,
                 WS_VTS = WS_VTP + (size_t)256 * LP * 2, WS_H1 = WS_VTS + (size_t)128 * 256 * 136 * 2, WS_H1B = WS_H1 + (size_t)MPAD * DM * 4,
                 WS_ACT = WS_H1B + (size_t)MPAD * DM * 2,
                 WS_A1 = WS_ACT, WS_QB = WS_A1 + (size_t)MPAD * DM * 2, WS_CBB = WS_QB + (size_t)MPAD * QW * 2, WS_UB = WS_CBB + (size_t)MPAD * CWID * 2,
                 WS_MIX = WS_UB + (size_t)MPAD * CWID * 2, WS_PART = WS_MIX + (size_t)MPAD * DM * 2, WS_END = WS_PART + (size_t)256 * 32 * 512 * 16;
static_assert(WS_PART - WS_ACT >= (size_t)MPAD * DFF * 2, "act overlay");
constexpr int SM_RS1 = 0, SM_RSQA = MPAD, SM_RSQC = 2 * MPAD, SM_RSQ1 = 3 * MPAD, SM_RSQ2 = 4 * MPAD, SM_ROPE = 5 * MPAD  , SM_FLAGS = 200000  ;

struct Params { const float* in[19]; float* out; unsigned char* ws; };

__device__ __forceinline__ unsigned cvt_pk_bf16(float lo, float hi) { unsigned r; asm volatile("v_cvt_pk_bf16_f32 %0, %1, %2" : "=v"(r) : "v"(lo), "v"(hi)); return r; }
__device__ __forceinline__ float bf_lo(unsigned w) { return __uint_as_float(w << 16); }
__device__ __forceinline__ float bf_hi(unsigned w) { return __uint_as_float(w & 0xffff0000u); }
__device__ __forceinline__ int my_tid(int wv) { int lane; asm volatile("v_mbcnt_lo_u32_b32 %0, -1, 0\n\tv_mbcnt_hi_u32_b32 %0, -1, %0" : "=v"(lane)); return wv * 64 + lane; }
__device__ __forceinline__ float wave_sum(float v) {
#pragma unroll
    for (int o = 32; o >= 1; o >>= 1) v += __shfl_xor(v, o);
    return v;
}

namespace pg8 {
constexpr int BM = 256, BK = 64, HALF = 128, HTB = HALF * BK * 2, STAGE_BYTES = 8 * HTB, NXCD = 8, WGM = 8;
__host__ __device__ __forceinline__ int lds_byte(int r, int c) { const int st = (r >> 4) * 2 + (c >> 5), rr = r & 15, cc = c & 31, ob = rr * 64 + cc * 2; return st * 1024 + (ob ^ (((ob >> 9) & 1) << 5)); }
__host__ __device__ __forceinline__ void stage_rc(int b, int& R, int& C) { const int st = b / 1024, sb = b % 1024, swz = sb ^ (((sb >> 9) & 1) << 5); R = (st >> 1) * 16 + swz / 64; C = (st & 1) * 32 + (swz % 64) / 2; }
__host__ __device__ __forceinline__ int perm32(int rho) { const int n = rho >> 4, i = rho & 15; return 8 * (i >> 2) + 4 * n + (i & 3); }
struct Unit { int pm, pn, kb, len, kind, seq; };
struct Gemm { const bf16_t* A; const bf16_t* Bt; int M, N, K; };
struct StaticOrder {
    int nM, nN, nt, j, x, base, nx, P;
    __device__ __forceinline__ void init(int M, int N, int K, int bid, int ksplit) {
        nM = M / BM; nN = N / BM; nt = K / BK; const int nwg = nM * nN;
        x = bid & 7; j = bid >> 3;
        const int q = nwg / NXCD, r = nwg % NXCD; nx = q + (x < r ? 1 : 0); base = x < r ? x * (q + 1) : r * (q + 1) + (x - r) * q;
        const int rem = nx & 31; P = 1;
        if (ksplit && rem > 0 && rem <= 8) { P = 32 / rem; if (P > 8) P = 8; }
    }
    __device__ __forceinline__ int piece_begin(int q) const { return 2 * ((q * (nt >> 1)) / P); }
    __device__ __forceinline__ bool next(int i, Unit& u) const {
        const int R = nx >> 5, rem = nx & 31;
        int o = i * 32 + j; u.kb = 0; u.len = nt; u.kind = 0; u.seq = i;
        if (i >= R) {
            if (i > R || j >= rem * P) return false;
            if (P > 1) { const int q = j % P; o = R * 32 + j / P; u.kb = piece_begin(q); u.len = piece_begin(q + 1) - u.kb; u.kind = (q == 0) ? 2 : 1; }
        }
        const int idx = base + o;
        const int nig = WGM * nN, gid = idx / nig, fm = gid * WGM, gsz = (nM - fm) < WGM ? (nM - fm) : WGM;
        u.pm = fm + ((idx % nig) % gsz); u.pn = (idx % nig) / gsz; return true;
    }
};

template <class Epi>
__device__ __forceinline__ void gemm_phase(LAS unsigned char* lds, const Gemm g, const StaticOrder& S, const Epi& E, int wv, f32x4* part, unsigned* flags) {
    int tid = my_tid(wv); asm volatile("" : "+v"(tid));
    const int wid = __builtin_amdgcn_readfirstlane(tid >> 6), lane = tid & 63, wr = wid >> 2, wc = wid & 3, fr = lane & 15, fq = lane >> 4;
    const int K = g.K;
    unsigned voffA[2];
#pragma unroll
    for (int i = 0; i < 2; ++i) voffA[i] = (unsigned)(tid * 16 + i * 8192);
#define voffB voffA
    const size_t kstep = (size_t)HTB;
    const size_t hstep = (size_t)(K / BK) * HTB;
    const size_t tstep = 2 * hstep;
    const unsigned ldsw = (unsigned)wid * 1024u;
    const int aoff = lds_byte(wr * 64 + fr, fq * 8), boff = lds_byte(wc * 32 + fr, fq * 8);
#define PG8_SA(b, h) (((b) * 2 + (h)) * HTB)
#define PG8_SB(b, h) ((4 + (b) * 2 + (h)) * HTB)
#define PG8_STAGE(bufoff, gbase, voff) do { _Pragma("unroll") for (int _i = 0; _i < 2; ++_i) \
        __builtin_amdgcn_global_load_lds((const unsigned*)((const char*)(gbase) + (voff)[_i]), (LAS unsigned*)(lds + (bufoff) + ldsw + _i * 8192), 16, 0, 0); } while (0)
#define PG8_LDA(dst, b, h) do { _Pragma("unroll") for (int m = 0; m < 4; ++m) _Pragma("unroll") for (int k = 0; k < 2; ++k) dst[m][k] = *(const LAS bf16x8*)(lds + PG8_SA(b, h) + aoff + m * 2048 + k * 1024); } while (0)
#define PG8_LDB(dst, b, h) do { _Pragma("unroll") for (int n = 0; n < 2; ++n) _Pragma("unroll") for (int k = 0; k < 2; ++k) dst[n][k] = *(const LAS bf16x8*)(lds + PG8_SB(b, h) + boff + n * 2048 + k * 1024); } while (0)
#define PG8_MMA(ai, bj, At, Bt) do { __builtin_amdgcn_s_setprio(1); _Pragma("unroll") for (int m = 0; m < 4; ++m) _Pragma("unroll") for (int n = 0; n < 2; ++n) _Pragma("unroll") for (int k = 0; k < 2; ++k) \
        acc[ai][bj][m][n] = __builtin_amdgcn_mfma_f32_16x16x32_bf16(Bt[n][k], At[m][k], acc[ai][bj][m][n], 0, 0, 0); __builtin_amdgcn_s_setprio(0); } while (0)
#define PG8_WAIT_V(n) asm volatile("s_waitcnt vmcnt(" #n ")" ::: "memory")
#define PG8_WAIT_L(n) asm volatile("s_waitcnt lgkmcnt(" #n ")" ::: "memory")
#define PG8_BAR __builtin_amdgcn_s_barrier()
#define PG8_SCHED __builtin_amdgcn_sched_barrier(0)
    Unit cur, nxt; int ui = 0;
    if (!S.next(0, cur)) return;
    f32x4 acc[2][2][4][2];
    E.init(acc, cur, wr, wc, fr, fq, cur.kind != 1);
    bf16x8 At[4][2], B0[2][2], B1[2][2];
    const __amdgpu_buffer_rsrc_t prsrc = __builtin_amdgcn_make_buffer_rsrc((void*)part, 0, 256 * 262144, 0x00020000);
    const char* cA = (const char*)g.A + (size_t)cur.pm * tstep + (size_t)cur.kb * kstep; const char* cB = (const char*)g.Bt + (size_t)cur.pn * tstep + (size_t)cur.kb * kstep;
    PG8_STAGE(PG8_SB(0, 0), cB, voffB); PG8_STAGE(PG8_SA(0, 0), cA, voffA); PG8_STAGE(PG8_SB(0, 1), cB + hstep, voffB); PG8_STAGE(PG8_SA(0, 1), cA + hstep, voffA);
    if (wr == 1) PG8_BAR;
    PG8_WAIT_V(4); PG8_BAR;
    PG8_STAGE(PG8_SB(1, 0), cB + kstep, voffB); PG8_STAGE(PG8_SA(1, 0), cA + kstep, voffA); PG8_STAGE(PG8_SB(1, 1), cB + hstep + kstep, voffB);
    PG8_WAIT_V(6); PG8_BAR;
    for (;;) {
        const bool has_next = S.next(ui + 1, nxt);
        const char* nA = has_next ? (const char*)g.A + (size_t)nxt.pm * tstep + (size_t)nxt.kb * kstep : cA; const char* nB = has_next ? (const char*)g.Bt + (size_t)nxt.pn * tstep + (size_t)nxt.kb * kstep : cB;
        const int nt = cur.len;
        int t = 0;
        do {
            const bool last = (t == nt - 2);
            const char* a1 = cA + (size_t)(t + 1) * kstep;
            const char* a2 = last ? nA : cA + (size_t)(t + 2) * kstep; const char* b2 = last ? nB : cB + (size_t)(t + 2) * kstep;
            const char* a3 = a2 + kstep; const char* b3 = b2 + kstep;
            PG8_LDB(B0, 0, 0); PG8_SCHED; PG8_LDA(At, 0, 0); PG8_STAGE(PG8_SA(1, 1), a1 + hstep, voffA);
            PG8_WAIT_L(8); PG8_BAR; PG8_WAIT_L(0); PG8_MMA(0, 0, At, B0); PG8_BAR; PG8_SCHED;
            PG8_LDB(B1, 0, 1); PG8_STAGE(PG8_SB(0, 0), b2, voffB);
            PG8_BAR; PG8_WAIT_L(0); PG8_MMA(0, 1, At, B1); PG8_BAR;
            PG8_LDA(At, 0, 1); PG8_STAGE(PG8_SA(0, 0), a2, voffA);
            PG8_BAR; PG8_WAIT_L(0); PG8_MMA(1, 0, At, B0); PG8_BAR; PG8_SCHED;
            PG8_STAGE(PG8_SB(0, 1), b2 + hstep, voffB);
            PG8_WAIT_V(6); PG8_BAR; PG8_MMA(1, 1, At, B1); PG8_BAR;
            PG8_LDB(B0, 1, 0); PG8_SCHED; PG8_LDA(At, 1, 0); PG8_STAGE(PG8_SA(0, 1), a2 + hstep, voffA);
            PG8_WAIT_L(8); PG8_BAR; PG8_WAIT_L(0); PG8_MMA(0, 0, At, B0); PG8_BAR; PG8_SCHED;
            PG8_LDB(B1, 1, 1); PG8_STAGE(PG8_SB(1, 0), b3, voffB);
            PG8_BAR; PG8_WAIT_L(0); PG8_MMA(0, 1, At, B1); PG8_BAR;
            PG8_LDA(At, 1, 1); PG8_STAGE(PG8_SA(1, 0), a3, voffA);
            PG8_BAR; PG8_WAIT_L(0); PG8_MMA(1, 0, At, B0); PG8_BAR; PG8_SCHED;
            PG8_STAGE(PG8_SB(1, 1), b3 + hstep, voffB);
            PG8_WAIT_V(6); PG8_BAR; PG8_MMA(1, 1, At, B1); PG8_BAR;
            t += 2;
        } while (t < nt);
        { int efr = fr, efq = fq, etid = tid; asm volatile("" : "+v"(efr), "+v"(efq), "+v"(etid));
          if (cur.kind == 1) {
              const unsigned off = (unsigned)blockIdx.x * 262144u + (unsigned)etid * 16u;
#pragma unroll
              for (int a = 0; a < 2; ++a)
#pragma unroll
                  for (int b = 0; b < 2; ++b)
#pragma unroll
                      for (int m = 0; m < 4; ++m)
#pragma unroll
                          for (int n = 0; n < 2; ++n) __builtin_amdgcn_raw_buffer_store_b128(__builtin_bit_cast(u32x4, acc[a][b][m][n]), prsrc, off, (((a * 2 + b) * 4 + m) * 2 + n) * 8192, 16);
              asm volatile("s_waitcnt vmcnt(0)" ::: "memory");
              if ((etid & 63) == 0) __hip_atomic_store(flags + blockIdx.x * 8 + wid, 1u, __ATOMIC_RELAXED, __HIP_MEMORY_SCOPE_AGENT);
          } else if (cur.kind == 0) E(acc, cur, wr, wc, efr, efq);
        }
        if (!has_next) break;
        { int efr = fr, efq = fq; asm volatile("" : "+v"(efr), "+v"(efq)); E.init(acc, nxt, wr, wc, efr, efq, nxt.kind != 1); }
        cur = nxt; cA = nA; cB = nB; ++ui;
    }
    PG8_WAIT_V(0);
    if (wr == 0) PG8_BAR;
    PG8_BAR;
    if (cur.kind == 2) {
        int efr = fr, efq = fq, etid = tid; asm volatile("" : "+v"(efr), "+v"(efq), "+v"(etid));
        for (int q = 1; q < S.P; ++q) {
            const int pb = (S.j + q) * 8 + S.x;
            while (__hip_atomic_load(flags + pb * 8 + wid, __ATOMIC_RELAXED, __HIP_MEMORY_SCOPE_AGENT) == 0u) __builtin_amdgcn_s_sleep(2);
            const unsigned off = (unsigned)pb * 262144u + (unsigned)etid * 16u;
#pragma unroll
            for (int a = 0; a < 2; ++a)
#pragma unroll
                for (int b = 0; b < 2; ++b) {
                    f32x4 t[8];
#pragma unroll
                    for (int m = 0; m < 4; ++m)
#pragma unroll
                        for (int n = 0; n < 2; ++n) t[m * 2 + n] = __builtin_bit_cast(f32x4, __builtin_amdgcn_raw_buffer_load_b128(prsrc, off, (((a * 2 + b) * 4 + m) * 2 + n) * 8192, 16));
#pragma unroll
                    for (int m = 0; m < 4; ++m)
#pragma unroll
                        for (int n = 0; n < 2; ++n) acc[a][b][m][n] += t[m * 2 + n];
                    __builtin_amdgcn_sched_barrier(0);
                }
        }
        E(acc, cur, wr, wc, efr, efq);
    }
#undef voffB
#undef PG8_SA
#undef PG8_SB
#undef PG8_STAGE
#undef PG8_LDA
#undef PG8_LDB
#undef PG8_MMA
#undef PG8_WAIT_V
#undef PG8_WAIT_L
#undef PG8_BAR
#undef PG8_SCHED
}
}
using pg8::Unit;
__device__ __forceinline__ size_t tiled_off(int row, int k, int KT) { return ((size_t)((row >> 7) * KT + (k >> 6)) << 14) + (size_t)pg8::lds_byte(row & 127, k & 63); }
__device__ __forceinline__ int inv_perm32(int w) { return (((w >> 2) & 1) << 4) | ((w >> 3) << 2) | (w & 3); }

__device__ __forceinline__ void unpack8(const u32x4 w, float (&f)[8]) { f[0] = bf_lo(w.x); f[1] = bf_hi(w.x); f[2] = bf_lo(w.y); f[3] = bf_hi(w.y); f[4] = bf_lo(w.z); f[5] = bf_hi(w.z); f[6] = bf_lo(w.w); f[7] = bf_hi(w.w); }
__device__ __forceinline__ void load8f(const float* s, float (&f)[8]) { const f32x4 a = *(const f32x4*)s, b = *(const f32x4*)(s + 4); f[0] = a[0]; f[1] = a[1]; f[2] = a[2]; f[3] = a[3]; f[4] = b[0]; f[5] = b[1]; f[6] = b[2]; f[7] = b[3]; }

typedef f32x4 Acc[2][2][4][2];

struct EpiIn {
    static constexpr bool MID = false;
    const float* sm; bf16_t *Qb, *Kp, *Ks, *Vtp, *Vts, *CBb, *Ub; float* out;
    __device__ __forceinline__ void init(Acc& acc, const Unit& u, int wr, int wc, int fr, int fq, bool first) const {
#pragma unroll
        for (int a = 0; a < 2; ++a)
#pragma unroll
            for (int b = 0; b < 2; ++b)
#pragma unroll
                for (int m = 0; m < 4; ++m)
#pragma unroll
                    for (int n = 0; n < 2; ++n) acc[a][b][m][n] = (f32x4){0.f, 0.f, 0.f, 0.f};
    }
    __device__ __forceinline__ void operator()(const Acc& acc, const Unit& u, int wr, int wc, int fr, int fq) const {
        const int pn = u.pn;
        const int lane16 = 16;
        float rsv[2][4];
#pragma unroll
        for (int ai = 0; ai < 2; ++ai)
#pragma unroll
            for (int m = 0; m < 4; ++m) rsv[ai][m] = sm[SM_RS1 + u.pm * 256 + ai * 128 + wr * 64 + m * 16 + fr];
#pragma unroll
        for (int q = 0; q < 4; ++q) asm volatile("" :: "v"(rsv[0][q]), "v"(rsv[1][q]));
#pragma unroll
        for (int aim = 0; aim < 4; ++aim) {
            const int ai = aim >> 1;
            f32x4 rc0[2], rc1[2], rs0[2], rs1[2];
#pragma unroll
            for (int mm = 0; mm < 2; ++mm) { rc0[mm] = (f32x4){1.f, 1.f, 1.f, 1.f}; rc1[mm] = rc0[mm]; rs0[mm] = (f32x4){0.f, 0.f, 0.f, 0.f}; rs1[mm] = rs0[mm]; }
            if (pn < 9 && ((wc & 1) == 0) && fq < 2) {
#pragma unroll
                for (int mm = 0; mm < 2; ++mm) { const float* rt = sm + SM_ROPE + (size_t)(u.pm * 256 + ai * 128 + wr * 64 + ((aim & 1) * 2 + mm) * 16 + fr) * 16;
                    rc0[mm] = *(const f32x4*)rt; rc1[mm] = *(const f32x4*)(rt + 4); rs0[mm] = *(const f32x4*)(rt + 8); rs1[mm] = *(const f32x4*)(rt + 12); }
            }
            if (pn < 9) {
#pragma unroll
                for (int mm = 0; mm < 2; ++mm)
#pragma unroll
                    for (int q = 0; q < 4; ++q) asm volatile("" :: "v"(rc0[mm][q]), "v"(rc1[mm][q]), "v"(rs0[mm][q]), "v"(rs1[mm][q]));
            }
#pragma unroll
            for (int mm = 0; mm < 2; ++mm) {
                const int m = (aim & 1) * 2 + mm;
                const int row = u.pm * 256 + ai * 128 + wr * 64 + m * 16 + fr;
                const float rs = rsv[ai][m];
                const bool is_p = row < LP, is_s = (row >= LP) && (row < MR);
                const int sr = row - LP, ss = sr >> 2, st = sr & 3;
                if (pn < 9) {
                    const bool ropew = ((wc & 1) == 0);
                    f32x4 c0 = rc0[mm], c1 = rc1[mm], s0 = rs0[mm], s1 = rs1[mm];
                    if (fq == 0) { s0 = -s0; s1 = -s1; }
#pragma unroll
                    for (int bj = 0; bj < 2; ++bj) {
                        f32x4 v0 = acc[ai][bj][m][0] * rs, v1 = acc[ai][bj][m][1] * rs;
                        if (ropew) {
                            f32x4 p0, p1;
#pragma unroll
                            for (int j = 0; j < 4; ++j) { p0[j] = __shfl_xor(v0[j], lane16); p1[j] = __shfl_xor(v1[j], lane16); }
                            v0 = v0 * c0 + p0 * s0; v1 = v1 * c1 + p1 * s1;
                        }
                        u32x4 w; w.x = cvt_pk_bf16(v0[0], v0[1]); w.y = cvt_pk_bf16(v0[2], v0[3]); w.z = cvt_pk_bf16(v1[0], v1[1]); w.w = cvt_pk_bf16(v1[2], v1[3]);
                        const int cl = bj * 128 + wc * 32 + 8 * fq;
                        if (pn < 8) { *(u32x4*)(Qb + (size_t)row * QW + pn * 256 + cl) = w; }
                        else if (is_p) {
                            *(u32x4*)(Kp + (size_t)row * 256 + cl) = w;
                            if (row >= LP - 128) { float* o = out + OFF_NKP + (size_t)(row - (LP - 128)) * 256 + cl; *(f32x4*)o = v0; *(f32x4*)(o + 4) = v1; }
                        } else if (is_s) {
                            *(u32x4*)(Ks + ((size_t)ss * 132 + 128 + st) * 256 + cl) = w;
                            float* o = out + OFF_NKS + ((size_t)ss * 128 + 124 + st) * 256 + cl; *(f32x4*)o = v0; *(f32x4*)(o + 4) = v1;
                        }
                    }
                } else if (pn == 9) {
#pragma unroll
                    for (int bj = 0; bj < 2; ++bj) {
                        const f32x4 v0 = acc[ai][bj][m][0] * rs, v1 = acc[ai][bj][m][1] * rs;
                        const int cl = bj * 128 + wc * 32 + 8 * fq;
                        const unsigned w0 = cvt_pk_bf16(v0[0], v0[1]), w1 = cvt_pk_bf16(v0[2], v0[3]), w2 = cvt_pk_bf16(v1[0], v1[1]), w3 = cvt_pk_bf16(v1[2], v1[3]);
                        if (is_p) {
                            bf16_t* d = Vtp + (size_t)cl * LP + row;
                            d[0] = (bf16_t)w0; d[LP] = (bf16_t)(w0 >> 16); d[2 * LP] = (bf16_t)w1; d[3 * LP] = (bf16_t)(w1 >> 16);
                            d[4 * LP] = (bf16_t)w2; d[5 * LP] = (bf16_t)(w2 >> 16); d[6 * LP] = (bf16_t)w3; d[7 * LP] = (bf16_t)(w3 >> 16);
                            if (row >= LP - 128) { float* o = out + OFF_NVP + (size_t)(row - (LP - 128)) * 256 + cl; *(f32x4*)o = v0; *(f32x4*)(o + 4) = v1; }
                        } else if (is_s) {
                            bf16_t* d = Vts + ((size_t)ss * 256 + cl) * 136 + 128 + st;
                            d[0] = (bf16_t)w0; d[136] = (bf16_t)(w0 >> 16); d[2 * 136] = (bf16_t)w1; d[3 * 136] = (bf16_t)(w1 >> 16);
                            d[4 * 136] = (bf16_t)w2; d[5 * 136] = (bf16_t)(w2 >> 16); d[6 * 136] = (bf16_t)w3; d[7 * 136] = (bf16_t)(w3 >> 16);
                            float* o = out + OFF_NVS + ((size_t)ss * 128 + 124 + st) * 256 + cl; *(f32x4*)o = v0; *(f32x4*)(o + 4) = v1;
                        }
                    }
                } else if (pn < 18) {
#pragma unroll
                    for (int bj = 0; bj < 2; ++bj) {
                        const f32x4 v0 = acc[ai][bj][m][0] * rs, v1 = acc[ai][bj][m][1] * rs;
                        u32x4 w; w.x = cvt_pk_bf16(v0[0], v0[1]); w.y = cvt_pk_bf16(v0[2], v0[3]); w.z = cvt_pk_bf16(v1[0], v1[1]); w.w = cvt_pk_bf16(v1[2], v1[3]);
                        *(u32x4*)(CBb + (size_t)row * CWID + (pn - 10) * 256 + bj * 128 + wc * 32 + 8 * fq) = w;
                    }
                } else {
                    const float r2 = rs * rs;
                    const f32x4 v0 = acc[ai][0][m][0] * acc[ai][1][m][0] * r2, v1 = acc[ai][0][m][1] * acc[ai][1][m][1] * r2;
                    const int j0 = (pn - 18) * 128 + wc * 32 + 8 * fq;
                    u32x4 w; w.x = cvt_pk_bf16(v0[0], v0[1]); w.y = cvt_pk_bf16(v0[2], v0[3]); w.z = cvt_pk_bf16(v1[0], v1[1]); w.w = cvt_pk_bf16(v1[2], v1[3]);
                    *(u32x4*)(Ub + (size_t)row * CWID + j0) = w;
                    if (is_p && row >= LP - 2) { float* o = out + OFF_NCP + (size_t)(row - (LP - 2)) * CWID + j0; *(f32x4*)o = v0; *(f32x4*)(o + 4) = v1; }
                    if (is_s && st >= 2) { float* o = out + OFF_NCS + ((size_t)ss * 2 + (st - 2)) * CWID + j0; *(f32x4*)o = v0; *(f32x4*)(o + 4) = v1; }
                }
            }
        }
    }
};

struct EpiOut {
    static constexpr bool MID = false;
    float* sm; const float *xp, *xs, *meta; float* H1; bf16_t* H1b;
    __device__ __forceinline__ void init(Acc& acc, const Unit& u, int wr, int wc, int fr, int fq, bool first) const {
#pragma unroll
        for (int ai = 0; ai < 2; ++ai)
#pragma unroll
            for (int m = 0; m < 4; ++m) {
                const int row = u.pm * 256 + ai * 128 + wr * 64 + m * 16 + fr;
                const float* hrow = row < 16 ? meta + (size_t)row * DM : (row < LP ? xp + (size_t)(row - 16) * DM : (row < MR ? xs + (size_t)(row - LP) * DM : nullptr));
#pragma unroll
                for (int bj = 0; bj < 2; ++bj) {
                    const int col = u.pn * 256 + bj * 128 + wc * 32 + 8 * fq;
                    f32x4 h0 = {0.f, 0.f, 0.f, 0.f}, h1 = h0;
                    if (first && hrow) { h0 = *(const f32x4*)(hrow + col); h1 = *(const f32x4*)(hrow + col + 4); }
                    acc[ai][bj][m][0] = h0; acc[ai][bj][m][1] = h1;
                }
            }
    }
    __device__ __forceinline__ void operator()(const Acc& acc, const Unit& u, int wr, int wc, int fr, int fq) const {
#pragma unroll
        for (int ai = 0; ai < 2; ++ai)
#pragma unroll
            for (int m = 0; m < 4; ++m) {
                const int row = u.pm * 256 + ai * 128 + wr * 64 + m * 16 + fr;
                float ssq = 0.f;
#pragma unroll
                for (int bj = 0; bj < 2; ++bj) {
                    const int col = u.pn * 256 + bj * 128 + wc * 32 + 8 * fq;
                    const f32x4 v0 = acc[ai][bj][m][0], v1 = acc[ai][bj][m][1];
                    float* o = H1 + (size_t)row * DM + col; *(f32x4*)o = v0; *(f32x4*)(o + 4) = v1;
                    u32x4 w; w.x = cvt_pk_bf16(v0[0], v0[1]); w.y = cvt_pk_bf16(v0[2], v0[3]); w.z = cvt_pk_bf16(v1[0], v1[1]); w.w = cvt_pk_bf16(v1[2], v1[3]);
                    if (row < LP) { const int t = row / 254, loc = row - 254 * t;
                        *(u32x4*)((char*)H1b + tiled_off(256 * t + loc, col, DM / 64)) = w;
                        if (loc < 2 && t > 0) *(u32x4*)((char*)H1b + tiled_off(256 * t - 2 + loc, col, DM / 64)) = w;
                    } else if (row < MR) *(u32x4*)((char*)H1b + tiled_off(8448 + (row - LP), col, DM / 64)) = w;
                    ssq += (v0[0] * v0[0] + v0[1] * v0[1]) + (v0[2] * v0[2] + v0[3] * v0[3]) + (v1[0] * v1[0] + v1[1] * v1[1]) + (v1[2] * v1[2] + v1[3] * v1[3]);
                }
                ssq += __shfl_xor(ssq, 16); ssq += __shfl_xor(ssq, 32);
                if (fq == 0) atomicAdd(sm + SM_RSQ1 + row, ssq);
            }
    }
};

constexpr int DPP_ROR1 = 0x121, DPP_ROR2 = 0x122;
__device__ __forceinline__ float dpp_ror1(float v) { return __builtin_bit_cast(float, __builtin_amdgcn_update_dpp(0, __builtin_bit_cast(int, v), DPP_ROR1, 0xf, 0xf, false)); }
__device__ __forceinline__ float dpp_shr1_old(float old, float v) { return __builtin_bit_cast(float, __builtin_amdgcn_update_dpp(__builtin_bit_cast(int, old), __builtin_bit_cast(int, v), 0x111, 0xf, 0xf, false)); }
__device__ __forceinline__ float dpp_shr2_old(float old, float v) { return __builtin_bit_cast(float, __builtin_amdgcn_update_dpp(__builtin_bit_cast(int, old), __builtin_bit_cast(int, v), 0x112, 0xf, 0xf, false)); }
__device__ __forceinline__ float dpp_ror2(float v) { return __builtin_bit_cast(float, __builtin_amdgcn_update_dpp(0, __builtin_bit_cast(int, v), DPP_ROR2, 0xf, 0xf, false)); }
struct EpiGU {
    static constexpr bool MID = false;
    const float* sm; bf16_t* Act; float* out; const float* fw; const float* stf; LAS float* X;
    LAS unsigned char* pre;
    __device__ __forceinline__ void init(Acc& acc, const Unit& u, int wr, int wc, int fr, int fq, bool first) const {
        if (wr == 0 && wc == 0) {
            const int lane = fq * 16 + fr;
            LAS unsigned char* b = pre + (u.seq & 1) * 2560;
            const float* rsrc = sm + SM_RSQ1 + (u.pm >= 33 ? LP + (u.pm - 33) * 256 : u.pm * 254) + lane;
#pragma unroll
            for (int i = 0; i < 4; ++i) __builtin_amdgcn_global_load_lds((const unsigned*)(rsrc + 64 * i), (LAS unsigned*)(b + 256 * i), 4, 0, 0);
#pragma unroll
            for (int i = 0; i < 6; ++i) __builtin_amdgcn_global_load_lds((const unsigned*)(fw + (size_t)(i >> 1) * DFF + u.pn * 128 + (i & 1) * 64 + lane), (LAS unsigned*)(b + 1024 + 256 * i), 4, 0, 0);
        }
#pragma unroll
        for (int a = 0; a < 2; ++a)
#pragma unroll
            for (int b = 0; b < 2; ++b)
#pragma unroll
                for (int m = 0; m < 4; ++m)
#pragma unroll
                    for (int n = 0; n < 2; ++n) acc[a][b][m][n] = (f32x4){0.f, 0.f, 0.f, 0.f};
    }
    __device__ __forceinline__ void operator()(const Acc& acc, const Unit& u, int wr, int wc, int fr, int fq) const {
        if (u.pm >= 33) run<true>(acc, u, wr, wc, fr, fq); else run<false>(acc, u, wr, wc, fr, fq);
    }
    template <bool samp>
    __device__ __forceinline__ void run(const Acc& acc, const Unit& u, int wr, int wc, int fr, int fq) const {
        const int rbase = samp ? LP + (u.pm - 33) * 256 : u.pm * 254;
        float rsv[2][4];
        const int j0 = u.pn * 128 + wc * 32 + 8 * fq;
        float w0[8], w1[8], w2[8];
        const LAS float* pb = (const LAS float*)(pre + (u.seq & 1) * 2560);
#pragma unroll
        for (int ai = 0; ai < 2; ++ai)
#pragma unroll
            for (int m = 0; m < 4; ++m) rsv[ai][m] = __builtin_amdgcn_rsqf(pb[ai * 128 + wr * 64 + m * 16 + fr] * (1.0f / 4096.0f) + EPS);
        { const LAS float* wp = pb + 256 + wc * 32 + 8 * fq;
          const f32x4 a0 = *(const LAS f32x4*)wp, a1 = *(const LAS f32x4*)(wp + 4), b0 = *(const LAS f32x4*)(wp + 128), b1 = *(const LAS f32x4*)(wp + 132), c0 = *(const LAS f32x4*)(wp + 256), c1 = *(const LAS f32x4*)(wp + 260);
#pragma unroll
          for (int q = 0; q < 4; ++q) { w0[q] = a0[q]; w0[q + 4] = a1[q]; w1[q] = b0[q]; w1[q + 4] = b1[q]; w2[q] = c0[q]; w2[q + 4] = c1[q]; } }
#pragma unroll
        for (int q = 0; q < 8; ++q) asm volatile("" :: "v"(w0[q]), "v"(w1[q]), "v"(w2[q]));
#pragma unroll
        for (int ai = 0; ai < 2; ++ai) {
            if (ai == 1 && wr == 1) continue;
            const float rs = rsv[ai][3];
            const f32x4 g0 = acc[ai][0][3][0] * rs, g1 = acc[ai][0][3][1] * rs;
            if (fr >= 14) { LAS float* x = X + ((wc * 3 + (wr == 0 ? ai : 2)) * 2 + (fr - 14)) * 32 + 8 * fq; *(LAS f32x4*)x = g0; *(LAS f32x4*)(x + 4) = g1; }
        }
        asm volatile("s_waitcnt lgkmcnt(0)" ::: "memory"); __builtin_amdgcn_s_barrier(); asm volatile("" ::: "memory"); __builtin_amdgcn_s_barrier(); asm volatile("" ::: "memory");
#pragma unroll
        for (int ai = 0; ai < 2; ++ai) {
            float pg[8];
#pragma unroll
            for (int mp = 0; mp < 4; ++mp) {
            float h2[1][8], h1[1][8];
            if (samp) {
                { const int li = ai * 128 + wr * 64 + mp * 16 + fr, t4 = li & 3, sq = ((u.pm - 33) * 256 + li) >> 2;
                    load8f(stf + ((size_t)sq * 2 + (t4 & 1)) * DFF + j0, h2[0]); load8f(stf + ((size_t)sq * 2 + 1) * DFF + j0, h1[0]); }
#pragma unroll
                for (int q = 0; q < 8; ++q) asm volatile("" :: "v"(h2[0][q]), "v"(h1[0][q]));
            }
#pragma unroll
            for (int mm = 0; mm < 1; ++mm) {
                const int m = mp;
                const int li = ai * 128 + wr * 64 + m * 16 + fr, row = rbase + li;
                const float rs = rsv[ai][m];
                const f32x4 g0 = acc[ai][0][m][0] * rs, g1 = acc[ai][0][m][1] * rs, u0 = acc[ai][1][m][0] * rs, u1 = acc[ai][1][m][1] * rs;
                float g[8] = {g0[0], g0[1], g0[2], g0[3], g1[0], g1[1], g1[2], g1[3]};
                float up[8] = {u0[0], u0[1], u0[2], u0[3], u1[0], u1[1], u1[2], u1[3]};
                float r1[8], r2[8];
                if (m > 0) {
#pragma unroll
                    for (int q = 0; q < 8; ++q) { r1[q] = dpp_shr1_old(dpp_ror1(pg[q]), g[q]); r2[q] = dpp_shr2_old(dpp_ror2(pg[q]), g[q]); }
                } else {
                    float xa[8], xb[8];
                    if (ai == 0 && wr == 0) {
#pragma unroll
                        for (int q = 0; q < 8; ++q) { xa[q] = 0.f; xb[q] = 0.f; }
                    } else {
                        const int src = (ai == 0) ? 0 : (wr == 0 ? 2 : 1);
                        const LAS float* x = X + ((wc * 3 + src) * 2) * 32 + 8 * fq;
                        const f32x4 a0 = *(const LAS f32x4*)x, a1 = *(const LAS f32x4*)(x + 4), b0 = *(const LAS f32x4*)(x + 32), b1 = *(const LAS f32x4*)(x + 36);
#pragma unroll
                        for (int q = 0; q < 4; ++q) { xa[q] = a0[q]; xa[q + 4] = a1[q]; xb[q] = b0[q]; xb[q + 4] = b1[q]; }
                    }
#pragma unroll
                    for (int q = 0; q < 8; ++q) { r1[q] = dpp_shr1_old(xb[q], g[q]); r2[q] = dpp_shr2_old(fr == 0 ? xa[q] : xb[q], g[q]); }
                }
                if (samp) {
                    const int t4 = li & 3;
#pragma unroll
                    for (int q = 0; q < 8; ++q) { r2[q] = t4 < 2 ? h2[mm][q] : r2[q]; r1[q] = t4 < 1 ? h1[mm][q] : r1[q]; }
                }
                float o[8];
#pragma unroll
                for (int q = 0; q < 8; ++q) { const float gc = r2[q] * w0[q] + r1[q] * w1[q] + g[q] * w2[q]; o[q] = gc * __builtin_amdgcn_rcpf(1.0f + __expf(-gc)) * up[q]; pg[q] = g[q]; }
                const bool valid = samp ? true : ((li >= 2 || u.pm == 0) && row < LP);
                if (valid) {
                    u32x4 w; w.x = cvt_pk_bf16(o[0], o[1]); w.y = cvt_pk_bf16(o[2], o[3]); w.z = cvt_pk_bf16(o[4], o[5]); w.w = cvt_pk_bf16(o[6], o[7]);
                    *(u32x4*)((char*)Act + tiled_off(row, j0, DFF / 64)) = w;
                    if (!samp && row >= LP - 2) { float* op = out + OFF_NFP + (size_t)(row - (LP - 2)) * DFF + j0; *(f32x4*)op = g0; *(f32x4*)(op + 4) = g1; }
                    if (samp && (li & 3) >= 2) { const int sr = row - LP; float* op = out + OFF_NFS + ((size_t)(sr >> 2) * 2 + ((sr & 3) - 2)) * DFF + j0; *(f32x4*)op = g0; *(f32x4*)(op + 4) = g1; }
                }
            }
            }
        }
    }
};

struct EpiDown {
    static constexpr bool MID = false;
    float* sm; const float* H1; float* out;
    __device__ __forceinline__ void init(Acc& acc, const Unit& u, int wr, int wc, int fr, int fq, bool first) const {
#pragma unroll
        for (int ai = 0; ai < 2; ++ai)
#pragma unroll
            for (int m = 0; m < 4; ++m) {
                const int row = u.pm * 256 + ai * 128 + wr * 64 + m * 16 + fr;
#pragma unroll
                for (int bj = 0; bj < 2; ++bj) {
                    const float* h = H1 + (size_t)row * DM + u.pn * 256 + bj * 128 + wc * 32 + 8 * fq;
                    f32x4 h0 = {0.f, 0.f, 0.f, 0.f}, h1 = h0;
                    if (first) { h0 = *(const f32x4*)h; h1 = *(const f32x4*)(h + 4); }
                    acc[ai][bj][m][0] = h0; acc[ai][bj][m][1] = h1;
                }
            }
    }
    __device__ __forceinline__ void operator()(const Acc& acc, const Unit& u, int wr, int wc, int fr, int fq) const {
#pragma unroll
        for (int ai = 0; ai < 2; ++ai)
#pragma unroll
            for (int m = 0; m < 4; ++m) {
                const int row = u.pm * 256 + ai * 128 + wr * 64 + m * 16 + fr;
                float* orow = (row >= 16 && row < LP) ? out + OFF_YP + (size_t)(row - 16) * DM : ((row >= LP && row < MR) ? out + OFF_YS + (size_t)(row - LP) * DM : nullptr);
                float ssq = 0.f;
                if (orow) {
#pragma unroll
                    for (int bj = 0; bj < 2; ++bj) {
                        const int col = u.pn * 256 + bj * 128 + wc * 32 + 8 * fq;
                        const f32x4 v0 = acc[ai][bj][m][0], v1 = acc[ai][bj][m][1];
                        *(f32x4*)(orow + col) = v0; *(f32x4*)(orow + col + 4) = v1;
                        ssq += (v0[0] * v0[0] + v0[1] * v0[1]) + (v0[2] * v0[2] + v0[3] * v0[3]) + (v1[0] * v1[0] + v1[1] * v1[1]) + (v1[2] * v1[2] + v1[3] * v1[3]);
                    }
                }
                ssq += __shfl_xor(ssq, 16); ssq += __shfl_xor(ssq, 32);
                if (fq == 0 && orow) atomicAdd(sm + SM_RSQ2 + row, ssq);
            }
    }
};

struct TileJob { const float* src; const float* g; bf16_t* dst; int N, Kd, k0, n0, orow; };
__device__ __forceinline__ TileJob decode_tile(const Params& p, int id) {
    TileJob j;
    if (id < 2176) { const int kt = id / 68, nt = id % 68; j.src = p.in[8]; j.N = INW; j.Kd = DM; j.k0 = kt * 128; j.n0 = nt * 128; j.g = p.in[7] + j.k0; j.dst = (bf16_t*)(p.ws + WS_W1);
        if (j.n0 < 4608) j.orow = j.n0; else if (j.n0 < 6656) j.orow = 4608 + ((j.n0 - 4608) >> 7) * 256; else j.orow = 4608 + ((j.n0 - 6656) >> 7) * 256 + 128; }
    else if (id < 3200) { id -= 2176; const int kt = id >> 5, nt = id & 31; j.src = p.in[13]; j.N = DM; j.Kd = DM; j.k0 = kt * 128; j.n0 = nt * 128; j.g = (j.k0 < 2048) ? p.in[11] + j.k0 : p.in[12] + (j.k0 - 2048);
        j.dst = (bf16_t*)(p.ws + WS_W2); j.orow = j.n0; }
    else if (id < 8704) { id -= 3200; const int kt = id / 172, nt = id % 172; j.src = p.in[15]; j.N = 2 * DFF; j.Kd = DM; j.k0 = kt * 128; j.n0 = nt * 128; j.g = p.in[14] + j.k0; j.dst = (bf16_t*)(p.ws + WS_W3);
        j.orow = (j.n0 < DFF) ? (j.n0 >> 7) * 256 : ((j.n0 - DFF) >> 7) * 256 + 128; }
    else { id -= 8704; const int kt = id >> 5, nt = id & 31; j.src = p.in[17]; j.N = DM; j.Kd = DFF; j.k0 = kt * 128; j.n0 = nt * 128; j.g = nullptr; j.dst = (bf16_t*)(p.ws + WS_W4); j.orow = j.n0; }
    return j;
}
constexpr int N_WTILES = 2176 + 1024 + 5504 + 2752;

__device__ __forceinline__ void tile_load(const TileJob& j, int tid, f32x4 (&r)[8]) {
    const int nq = tid & 31, kp = tid >> 5;
#pragma unroll
    for (int ps = 0; ps < 4; ++ps) {
        const int kpp = kp + 16 * ps;
        const float* s = j.src + (size_t)(j.k0 + 2 * kpp) * j.N + j.n0 + 4 * nq;
        r[2 * ps] = __builtin_nontemporal_load((const f32x4*)s);
        r[2 * ps + 1] = __builtin_nontemporal_load((const f32x4*)(s + j.N));
    }
}
__device__ __forceinline__ void tile_store(const TileJob& j, int tid, const f32x4 (&r)[8], LAS unsigned* T) {
    const int nq = tid & 31, kp = tid >> 5;
#pragma unroll
    for (int ps = 0; ps < 4; ++ps) {
        const int kpp = kp + 16 * ps;
        float g0 = 1.f, g1 = 1.f;
        if (j.g) { g0 = j.g[2 * kpp]; g1 = j.g[2 * kpp + 1]; }
#pragma unroll
        for (int i = 0; i < 4; ++i) T[(4 * nq + i) * 65 + kpp] = cvt_pk_bf16(r[2 * ps][i] * g0, r[2 * ps + 1][i] * g1);
    }
    __syncthreads();
    const int n = tid >> 2, kq = tid & 3;
    u32x4 w[4];
#pragma unroll
    for (int q = 0; q < 4; ++q)
#pragma unroll
        for (int i = 0; i < 4; ++i) w[q][i] = T[n * 65 + 16 * kq + 4 * q + i];
    const int slot = (n & ~31) | inv_perm32(n & 31);
    char* d = (char*)j.dst + ((size_t)((j.orow >> 7) * (j.Kd >> 6) + (j.k0 >> 6) + (kq >> 1)) << 14);
#pragma unroll
    for (int q = 0; q < 4; ++q) *(u32x4*)(d + pg8::lds_byte(slot, 32 * (kq & 1) + 8 * q)) = w[q];
    __syncthreads();
}

__device__ __forceinline__ void phase0(const Params& p, LAS unsigned char* lds, int wv) {
    int tid = my_tid(wv); asm volatile("" : "+v"(tid));
    const int lane = tid & 63, wid = tid >> 6;
    const int gthreads = gridDim.x * 512, gtid = blockIdx.x * 512 + tid;
    const int gwaves = gridDim.x * 8, gwave = blockIdx.x * 8 + wid;
    float* sm = (float*)(p.ws + WS_SM);
    {
        bf16_t* A1 = (bf16_t*)(p.ws + WS_A1);
        for (int row = gwave; row < MPAD; row += gwaves) {
            const float* src = row < 16 ? p.in[6] + (size_t)row * DM : (row < LP ? p.in[0] + (size_t)(row - 16) * DM : (row < MR ? p.in[1] + (size_t)(row - LP) * DM : nullptr));
            float ss = 0.f;
#pragma unroll 4
            for (int it = 0; it < 16; ++it) {
                f32x4 v = {0.f, 0.f, 0.f, 0.f};
                if (src) v = *(const f32x4*)(src + it * 256 + lane * 4);
                ss += (v[0] * v[0] + v[1] * v[1]) + (v[2] * v[2] + v[3] * v[3]);
                u32x2 w; w.x = cvt_pk_bf16(v[0], v[1]); w.y = cvt_pk_bf16(v[2], v[3]);
                *(u32x2*)((char*)A1 + tiled_off(row, it * 256 + lane * 4, DM / 64)) = w;
            }
            ss = wave_sum(ss);
            if (lane == 0) { sm[SM_RS1 + row] = __builtin_amdgcn_rsqf(ss * (1.0f / 4096.0f) + EPS); sm[SM_RSQA + row] = 0.f; sm[SM_RSQC + row] = 0.f; sm[SM_RSQ1 + row] = 0.f; sm[SM_RSQ2 + row] = 0.f; }
            if (lane < 8) {
                const float inv[8] = {1.0f, 0.1939227432012558f, 0.03760603070259094f, 0.007292664609849453f, 0.0014142135623842478f, 0.00027424818836152554f, 5.318296098266728e-05f, 1.0313386155758053e-05f};
                float iv = inv[0];
#pragma unroll
                for (int q = 1; q < 8; ++q) iv = (lane == q) ? inv[q] : iv;
                const int pos = row < LP ? row : (row < MR ? 8192 + ((row - LP) & 3) : 0);
                const float ang = (float)pos * iv;
                double rev = (double)ang * 0.15915494309189535; rev -= __builtin_floor(rev);
                const float fr = (float)rev;
                sm[SM_ROPE + (size_t)row * 16 + lane] = __builtin_amdgcn_cosf(fr);
                sm[SM_ROPE + (size_t)row * 16 + 8 + lane] = __builtin_amdgcn_sinf(fr);
            }
        }
    }
    { unsigned* fl = (unsigned*)(sm + SM_FLAGS); for (int i = gtid; i < 8192; i += gthreads) fl[i] = 0u; }
    { u32x4* z = (u32x4*)(p.ws + WS_MIX + ((size_t)(MR >> 7) * (DM / 64) << 14)); const int n16 = (MPAD / 128 - (MR >> 7)) * (DM / 64) * 16384 / 16; for (int i = gtid; i < n16; i += gthreads) z[i] = (u32x4){0u, 0u, 0u, 0u}; }
    { u32x4* z = (u32x4*)(p.ws + WS_H1B + ((size_t)64 * (DM / 64) << 14)); const int n16 = 2 * (DM / 64) * 16384 / 16; for (int i = gtid; i < n16; i += gthreads) z[i] = (u32x4){0u, 0u, 0u, 0u}; }
    {
        const float* ck = p.in[2]; bf16_t* Ks = (bf16_t*)(p.ws + WS_KS);
        for (int i = gtid; i < 128 * 128 * 32; i += gthreads) {
            const int c8 = i & 31, u = (i >> 5) & 127, s = i >> 12;
            const float* src = ck + ((size_t)s * 128 + u) * 256 + c8 * 8;
            const f32x4 a = *(const f32x4*)src, b = *(const f32x4*)(src + 4);
            u32x4 w; w.x = cvt_pk_bf16(a[0], a[1]); w.y = cvt_pk_bf16(a[2], a[3]); w.z = cvt_pk_bf16(b[0], b[1]); w.w = cvt_pk_bf16(b[2], b[3]);
            *(u32x4*)(Ks + ((size_t)s * 132 + u) * 256 + c8 * 8) = w;
            if (u >= 4) { float* o = p.out + OFF_NKS + ((size_t)s * 128 + (u - 4)) * 256 + c8 * 8; *(f32x4*)o = a; *(f32x4*)(o + 4) = b; }
        }
    }
    {
        const float* cv = p.in[3]; bf16_t* Vts = (bf16_t*)(p.ws + WS_VTS);
        for (int i = gtid; i < 128 * 32 * 256; i += gthreads) {
            const int c = i & 255, uq = (i >> 8) & 31, s = i >> 13;
            const float* src = cv + ((size_t)s * 128 + 4 * uq) * 256 + c;
            u32x2 w; w.x = cvt_pk_bf16(src[0], src[256]); w.y = cvt_pk_bf16(src[512], src[768]);
            *(u32x2*)(Vts + ((size_t)s * 256 + c) * 136 + 4 * uq) = w;
        }
        for (int i = gtid; i < 128 * 124 * 64; i += gthreads) {
            const int c4 = i & 63, r = (i >> 6) % 124, s = (i >> 6) / 124;
            *(f32x4*)(p.out + OFF_NVS + ((size_t)s * 128 + r) * 256 + c4 * 4) = *(const f32x4*)(cv + ((size_t)s * 128 + r + 4) * 256 + c4 * 4);
        }
    }
    {
        LAS unsigned* T = (LAS unsigned*)lds;
        int id = blockIdx.x;
        f32x4 cur[8], n1[8], n2[8];
        const int G = gridDim.x;
        TileJob jc = decode_tile(p, id < N_WTILES ? id : 0), j1 = decode_tile(p, id + G < N_WTILES ? id + G : 0);
        if (id < N_WTILES) tile_load(jc, tid, cur);
        if (id + G < N_WTILES) tile_load(j1, tid, n1);
        while (id < N_WTILES) {
            const int id2 = id + 2 * G;
            TileJob j2 = decode_tile(p, id2 < N_WTILES ? id2 : 0);
            if (id2 < N_WTILES) tile_load(j2, tid, n2);
            tile_store(jc, tid, cur, T);
#pragma unroll
            for (int q = 0; q < 8; ++q) { cur[q] = n1[q]; n1[q] = n2[q]; }
            jc = j1; j1 = j2; id += G;
        }
    }
}

__device__ __forceinline__ void attn_item(const Params& p, int grp, int lane) {
    const int fr = lane & 15, fq = lane >> 4;
    const bf16_t* Qb = (const bf16_t*)(p.ws + WS_QB);
    bf16_t* Mix = (bf16_t*)(p.ws + WS_MIX);
    const bf16_t* Kb; const bf16_t* Vt; int vstride, qpos0, R0;
    if (grp < LP / 2) { Kb = (const bf16_t*)(p.ws + WS_KP); Vt = (const bf16_t*)(p.ws + WS_VTP); vstride = LP; qpos0 = grp * 2; R0 = grp * 2; }
    else { const int sg = grp - LP / 2, s = sg >> 1, hf = sg & 1; Kb = (const bf16_t*)(p.ws + WS_KS) + (size_t)s * 132 * 256; Vt = (const bf16_t*)(p.ws + WS_VTS) + (size_t)s * 256 * 136; vstride = 136;
        qpos0 = 128 + 2 * hf; R0 = LP + 4 * s + 2 * hf; }
    const int kstart = (qpos0 & ~3) - 156;
    const int tok = fr >> 3, g = fr & 7, qidx = qpos0 + tok;
    f32x4 O[4][4];
    float ssq = 0.f;
#pragma unroll
    for (int kvh = 0; kvh < 4; ++kvh) {
        bf16x8 qf[2];
        { const bf16_t* qp = Qb + (size_t)(R0 + tok) * QW + (kvh * 8 + g) * 64 + fq * 8; qf[0] = *(const bf16x8*)qp; qf[1] = *(const bf16x8*)(qp + 32); }
        f32x4 S[10];
#pragma unroll
        for (int kt = 0; kt < 10; ++kt) {
            int key = kstart + kt * 16 + fr; key = key < 0 ? 0 : key;
            const bf16_t* kp = Kb + (size_t)key * 256 + kvh * 64 + fq * 8;
            const bf16x8 k0 = *(const bf16x8*)kp, k1 = *(const bf16x8*)(kp + 32);
            f32x4 a = {0.f, 0.f, 0.f, 0.f};
            a = __builtin_amdgcn_mfma_f32_16x16x32_bf16(k0, qf[0], a, 0, 0, 0);
            a = __builtin_amdgcn_mfma_f32_16x16x32_bf16(k1, qf[1], a, 0, 0, 0);
            S[kt] = a;
        }
        const float sink = p.in[9][kvh * 8 + g];
        float mx = sink;
#pragma unroll
        for (int kt = 0; kt < 10; ++kt)
#pragma unroll
            for (int i = 0; i < 4; ++i) {
                const int kidx = kstart + kt * 16 + fq * 4 + i;
                const bool valid = (kidx >= 0) && (kidx <= qidx) && (kidx > qidx - 128);
                const float sv = valid ? S[kt][i] * 0.125f : -1e30f;
                S[kt][i] = sv; mx = fmaxf(mx, sv);
            }
        mx = fmaxf(mx, __shfl_xor(mx, 16)); mx = fmaxf(mx, __shfl_xor(mx, 32));
        float sum = 0.f;
#pragma unroll
        for (int kt = 0; kt < 10; ++kt)
#pragma unroll
            for (int i = 0; i < 4; ++i) { const float e = __expf(S[kt][i] - mx); S[kt][i] = e; sum += e; }
        sum += __shfl_xor(sum, 16); sum += __shfl_xor(sum, 32);
        sum += __expf(sink - mx);
        const float inv = 1.0f / sum;
#pragma unroll
        for (int dt = 0; dt < 4; ++dt) O[kvh][dt] = (f32x4){0.f, 0.f, 0.f, 0.f};
#pragma unroll
        for (int ks = 0; ks < 5; ++ks) {
            u32x4 pw; pw.x = cvt_pk_bf16(S[2 * ks][0], S[2 * ks][1]); pw.y = cvt_pk_bf16(S[2 * ks][2], S[2 * ks][3]);
            pw.z = cvt_pk_bf16(S[2 * ks + 1][0], S[2 * ks + 1][1]); pw.w = cvt_pk_bf16(S[2 * ks + 1][2], S[2 * ks + 1][3]);
            const bf16x8 pf = __builtin_bit_cast(bf16x8, pw);
            int kg0 = kstart + ks * 32 + fq * 4, kg1 = kg0 + 16;
            kg0 = kg0 < 0 ? 0 : kg0; kg1 = kg1 < 0 ? 0 : kg1;
#pragma unroll
            for (int dt = 0; dt < 4; ++dt) {
                const bf16_t* vrow = Vt + (size_t)(kvh * 64 + dt * 16 + fr) * vstride;
                const u32x2 lo = *(const u32x2*)(vrow + kg0), hi = *(const u32x2*)(vrow + kg1);
                u32x4 w; w.x = lo.x; w.y = lo.y; w.z = hi.x; w.w = hi.y;
                O[kvh][dt] = __builtin_amdgcn_mfma_f32_16x16x32_bf16(__builtin_bit_cast(bf16x8, w), pf, O[kvh][dt], 0, 0, 0);
            }
        }
#pragma unroll
        for (int dt = 0; dt < 4; ++dt) { O[kvh][dt] *= inv; const f32x4 o = O[kvh][dt]; ssq += (o[0] * o[0] + o[1] * o[1]) + (o[2] * o[2] + o[3] * o[3]); }
    }
    ssq += __shfl_xor(ssq, 16); ssq += __shfl_xor(ssq, 32); ssq += __shfl_xor(ssq, 1); ssq += __shfl_xor(ssq, 2); ssq += __shfl_xor(ssq, 4);
    const float rs = __builtin_amdgcn_rsqf(ssq * (1.0f / 2048.0f) + EPS);
#pragma unroll
    for (int kvh = 0; kvh < 4; ++kvh) {
#pragma unroll
        for (int dt = 0; dt < 4; ++dt) {
            const f32x4 o = O[kvh][dt] * rs;
            u32x2 w; w.x = cvt_pk_bf16(o[0], o[1]); w.y = cvt_pk_bf16(o[2], o[3]);
            *(u32x2*)((char*)Mix + tiled_off(R0 + tok, (kvh * 8 + g) * 64 + dt * 16 + fq * 4, DM / 64)) = w;
        }
    }
}

__device__ __forceinline__ void conv_row(const Params& p, int row, int lane) {
    const bf16_t* Ub = (const bf16_t*)(p.ws + WS_UB); const bf16_t* CBb = (const bf16_t*)(p.ws + WS_CBB);
    bf16_t* Mix = (bf16_t*)(p.ws + WS_MIX);
    const float* cw = p.in[10];
    const bool samp = row >= LP; const int sr = row - LP, s = sr >> 2, t = sr & 3;
    float ss = 0.f;
    float o[4][8];
#pragma unroll
    for (int it = 0; it < 4; ++it) {
        const int col = it * 512 + lane * 8;
        float u0[8], u1[8], u2[8], cb[8], w0[8], w1[8], w2[8];
        unpack8(*(const u32x4*)(Ub + (size_t)row * CWID + col), u2);
        unpack8(*(const u32x4*)(CBb + (size_t)row * CWID + col), cb);
        const bool has1 = samp ? (t >= 1) : (row >= 1), has2 = samp ? (t >= 2) : (row >= 2);
        if (has1) unpack8(*(const u32x4*)(Ub + (size_t)(row - 1) * CWID + col), u1);
        else if (samp) load8f(p.in[4] + ((size_t)s * 2 + 1) * CWID + col, u1);
        else {
#pragma unroll
            for (int q = 0; q < 8; ++q) u1[q] = 0.f; }
        if (has2) unpack8(*(const u32x4*)(Ub + (size_t)(row - 2) * CWID + col), u0);
        else if (samp) load8f(p.in[4] + ((size_t)s * 2 + t) * CWID + col, u0);
        else {
#pragma unroll
            for (int q = 0; q < 8; ++q) u0[q] = 0.f; }
        load8f(cw + col, w0); load8f(cw + CWID + col, w1); load8f(cw + 2 * CWID + col, w2);
#pragma unroll
        for (int q = 0; q < 8; ++q) { o[it][q] = cb[q] * (u0[q] * w0[q] + u1[q] * w1[q] + u2[q] * w2[q]); ss += o[it][q] * o[it][q]; }
    }
    ss = wave_sum(ss);
    const float rs = __builtin_amdgcn_rsqf(ss * (1.0f / 2048.0f) + EPS);
#pragma unroll
    for (int it = 0; it < 4; ++it) {
        const int col = it * 512 + lane * 8;
        u32x4 w; w.x = cvt_pk_bf16(o[it][0] * rs, o[it][1] * rs); w.y = cvt_pk_bf16(o[it][2] * rs, o[it][3] * rs); w.z = cvt_pk_bf16(o[it][4] * rs, o[it][5] * rs); w.w = cvt_pk_bf16(o[it][6] * rs, o[it][7] * rs);
        *(u32x4*)((char*)Mix + tiled_off(row, 2048 + col, DM / 64)) = w;
    }
}

__device__ __forceinline__ void phase2(const Params& p, int wv) {
    int tid = my_tid(wv); asm volatile("" : "+v"(tid));
    const int lane = tid & 63, wid = __builtin_amdgcn_readfirstlane(tid >> 6);
    const int gwaves = gridDim.x * 8, gwave = (((int)blockIdx.x & 7) * ((int)gridDim.x >> 3) + ((int)blockIdx.x >> 3)) * 8 + wid;
    constexpr int NGRP = LP / 2 + 256;
    for (int it = gwave; it < NGRP; it += gwaves) attn_item(p, it, lane);
    const int heavy = (NGRP > 2 * gwaves && NGRP < 3 * gwaves) ? NGRP - 2 * gwaves : 0;
    if (gwave >= heavy) for (int row = gwave - heavy; row < MR; row += gwaves - heavy) conv_row(p, row, lane);
}

__device__ __forceinline__ void phase7(const Params& p, int wv) {
    int tid = my_tid(wv); asm volatile("" : "+v"(tid));
    const int lane = tid & 63, wid = tid >> 6;
    const int gwaves = gridDim.x * 8, gwave = blockIdx.x * 8 + wid;
    const float* sm = (const float*)(p.ws + WS_SM); const float* gf = p.in[18];
    for (int row = 16 + gwave; row < MR; row += gwaves) {
        float* o = row < LP ? p.out + OFF_YP + (size_t)(row - 16) * DM : p.out + OFF_YS + (size_t)(row - LP) * DM;
        const float rs = __builtin_amdgcn_rsqf(sm[SM_RSQ2 + row] * (1.0f / 4096.0f) + EPS);
#pragma unroll 4
        for (int it = 0; it < 16; ++it) {
            const int c = it * 256 + lane * 4;
            const f32x4 v = *(const f32x4*)(o + c), g = *(const f32x4*)(gf + c);
            *(f32x4*)(o + c) = v * rs * g;
        }
    }
}

__device__ __forceinline__ void grid_barrier(unsigned* ctr, unsigned target, int wv) {
    asm volatile("s_waitcnt vmcnt(0)" ::: "memory");
    __syncthreads();
    if (my_tid(wv) == 0) {
        __builtin_amdgcn_fence(__ATOMIC_RELEASE, "agent");
        asm volatile("s_waitcnt vmcnt(0)" ::: "memory");
        __hip_atomic_fetch_add(ctr, 1u, __ATOMIC_RELAXED, __HIP_MEMORY_SCOPE_AGENT);
        while (__hip_atomic_load(ctr, __ATOMIC_RELAXED, __HIP_MEMORY_SCOPE_AGENT) < target) __builtin_amdgcn_s_sleep(2);
        __builtin_amdgcn_fence(__ATOMIC_ACQUIRE, "agent");
        asm volatile("s_waitcnt vmcnt(0)" ::: "memory");
    }
    __syncthreads();
}

__device__ __forceinline__ Params load_params() {
#if defined(__HIP_DEVICE_COMPILE__)
    typedef const __attribute__((address_space(4))) Params* KParams;
    KParams k = (KParams)__builtin_amdgcn_kernarg_segment_ptr(); asm volatile("" : "+s"(k));
    Params r;
#pragma unroll
    for (int i = 0; i < 19; ++i) r.in[i] = k->in[i];
    r.out = k->out; r.ws = k->ws; return r;
#else
    return Params{};
#endif
}

__global__ void __launch_bounds__(512, 2) fwd_megakernel(Params p_unused) {
    extern __shared__ __attribute__((aligned(16))) unsigned char lds_raw[];
    LAS unsigned char* lds = (LAS unsigned char*)lds_raw;
    cg::grid_group grid = cg::this_grid();
    const int wv = __builtin_amdgcn_readfirstlane((int)threadIdx.x >> 6);
#define PHASE_PTRS const Params p = load_params(); float* sm = (float*)(p.ws + WS_SM); unsigned* flags = (unsigned*)(sm + SM_FLAGS); unsigned* gbar = flags + 8192 + 32; f32x4* part = (f32x4*)(p.ws + WS_PART); (void)gbar; (void)flags; (void)part

    { PHASE_PTRS; phase0(p, lds, wv); if (p.ws == nullptr) grid.sync();
      grid_barrier(gbar, 1u * gridDim.x, wv); }
    {
        PHASE_PTRS;
        pg8::Gemm g{(const bf16_t*)(p.ws + WS_A1), (const bf16_t*)(p.ws + WS_W1), MPAD, INW, DM};
        pg8::StaticOrder S; S.init(MPAD, INW, DM, blockIdx.x, 0);
        EpiIn E{sm, (bf16_t*)(p.ws + WS_QB), (bf16_t*)(p.ws + WS_KP), (bf16_t*)(p.ws + WS_KS), (bf16_t*)(p.ws + WS_VTP), (bf16_t*)(p.ws + WS_VTS), (bf16_t*)(p.ws + WS_CBB), (bf16_t*)(p.ws + WS_UB), p.out};
        pg8::gemm_phase(lds, g, S, E, wv, part, flags);
        grid_barrier(gbar, 2u * gridDim.x, wv);
    }
    { PHASE_PTRS; phase2(p, wv); grid_barrier(gbar, 3u * gridDim.x, wv); }
    {
        PHASE_PTRS;
        pg8::Gemm g{(const bf16_t*)(p.ws + WS_MIX), (const bf16_t*)(p.ws + WS_W2), MPAD, DM, DM};
        pg8::StaticOrder S; S.init(MPAD, DM, DM, blockIdx.x, 1);
        EpiOut E{sm, p.in[0], p.in[1], p.in[6], (float*)(p.ws + WS_H1), (bf16_t*)(p.ws + WS_H1B)};
        pg8::gemm_phase(lds, g, S, E, wv, part, flags);
        grid_barrier(gbar, 4u * gridDim.x, wv);
    }
    {
        PHASE_PTRS;
        pg8::Gemm g{(const bf16_t*)(p.ws + WS_H1B), (const bf16_t*)(p.ws + WS_W3), MPAD, 2 * DFF, DM};
        pg8::StaticOrder S; S.init(MPAD, 2 * DFF, DM, blockIdx.x, 0);
        EpiGU E{sm, (bf16_t*)(p.ws + WS_ACT), p.out, p.in[16], p.in[5], (LAS float*)(lds + pg8::STAGE_BYTES), lds + pg8::STAGE_BYTES + 3072};
        pg8::gemm_phase(lds, g, S, E, wv, part, flags);
        grid_barrier(gbar, 5u * gridDim.x, wv);
    }
    {
        PHASE_PTRS;
        pg8::Gemm g{(const bf16_t*)(p.ws + WS_ACT), (const bf16_t*)(p.ws + WS_W4), MPAD, DM, DFF};
        pg8::StaticOrder S; S.init(MPAD, DM, DFF, blockIdx.x, 1);
        EpiDown E{sm, (const float*)(p.ws + WS_H1), p.out};
        pg8::gemm_phase(lds, g, S, E, wv, part, flags + 2048);
        grid_barrier(gbar, 6u * gridDim.x, wv);
    }
    { PHASE_PTRS; phase7(p, wv); }
#undef PHASE_PTRS
}

extern "C" void kernel_launch(void* const* d_in, const int* in_sizes, int n_in, void* d_out, int out_size, void* d_ws, size_t ws_size, hipStream_t stream) {
    constexpr int LDS_BYTES = pg8::STAGE_BYTES + 8192;
    static int grid = 0;
    if (grid == 0) {
        if (n_in != 19 || (size_t)out_size != OUT_TOTAL || ws_size < WS_END) { fprintf(stderr, "kernel_launch: unexpected shapes (n_in %d out %d ws %zu need %zu)\n", n_in, out_size, ws_size, (size_t)WS_END); grid = -1; return; }
        int dev = 0, cus = 0, per_cu = 0;
        (void)hipGetDevice(&dev);
        (void)hipDeviceGetAttribute(&cus, hipDeviceAttributeMultiprocessorCount, dev);
        if (hipFuncSetAttribute((const void*)fwd_megakernel, hipFuncAttributeMaxDynamicSharedMemorySize, LDS_BYTES) != hipSuccess) { fprintf(stderr, "kernel_launch: hipFuncSetAttribute failed\n"); grid = -1; return; }
        (void)hipOccupancyMaxActiveBlocksPerMultiprocessor(&per_cu, (const void*)fwd_megakernel, 512, LDS_BYTES);
        if (per_cu < 1) per_cu = 1;
        (void)hipGetLastError();
        grid = cus;
        if (grid != 256) { fprintf(stderr, "kernel_launch: built for 256 CUs, found %d\n", cus); grid = -1; return; }
        fprintf(stderr, "kernel_launch: cus %d per_cu %d grid %d\n", cus, per_cu, grid);
    }
    if (grid < 0) return;
    (void)hipMemsetAsync((char*)d_ws + WS_SM + (size_t)(SM_FLAGS + 8192 + 32) * 4, 0, 64, stream);
    Params p{};
    for (int i = 0; i < 19; ++i) p.in[i] = (const float*)d_in[i];
    p.out = (float*)d_out; p.ws = (unsigned char*)d_ws;
    void* args[] = {&p};
    hipError_t e = hipLaunchCooperativeKernel((const void*)fwd_megakernel, dim3(grid), dim3(512), args, LDS_BYTES, stream);
    if (e != hipSuccess) fprintf(stderr, "cooperative launch failed: %s (grid %d)\n", hipGetErrorString(e), grid);
}
```

```cpp
#include <hip/hip_runtime.h>
#include <hip/hip_cooperative_groups.h>
#include <cstdio>
namespace cg = cooperative_groups;

#define LAS __attribute__((address_space(3)))
typedef unsigned short bf16_t;
typedef short bf16x8 __attribute__((ext_vector_type(8)));
typedef float f32x4 __attribute__((ext_vector_type(4)));
typedef float f32x2 __attribute__((ext_vector_type(2)));
typedef unsigned u32x4 __attribute__((ext_vector_type(4)));
typedef unsigned u32x2 __attribute__((ext_vector_type(2)));

constexpr int DM = 4096, LP = 8208  , NSR = 512  , MR = LP + NSR  , MPAD = 8960  ;
constexpr int QW = 2048, CWID = 2048, INW = 8704, DFF = 11008;
constexpr float EPS = 1e-5f;
constexpr size_t OFF_YP = 0, OFF_YS = OFF_YP + (size_t)8192 * 4096, OFF_NKP = OFF_YS + (size_t)512 * 4096, OFF_NVP = OFF_NKP + 32768, OFF_NCP = OFF_NVP + 32768,
                 OFF_NFP = OFF_NCP + 4096, OFF_NKS = OFF_NFP + 22016, OFF_NVS = OFF_NKS + 4194304, OFF_NCS = OFF_NVS + 4194304, OFF_NFS = OFF_NCS + 524288,
                 OUT_TOTAL = OFF_NFS + 2818048;
constexpr size_t WS_W1 = 0, WS_W2 = WS_W1 + (size_t)INW * DM * 2, WS_W3 = WS_W2 + (size_t)DM * DM * 2, WS_W4 = WS_W3 + (size_t)2 * DFF * DM * 2,
                 WS_SM = WS_W4 + (size_t)DM * DFF * 2, WS_KP = WS_SM + (1u << 20), WS_KS = WS_KP + (size_t)LP * 256 * 2, WS_VTP = WS_KS + (size_t)128 * 132 * 256 * 2,
                 WS_VTS = WS_VTP + (size_t)256 * LP * 2, WS_H1 = WS_VTS + (size_t)128 * 256 * 136 * 2, WS_H1B = WS_H1 + (size_t)MPAD * DM * 4,
                 WS_ACT = WS_H1B + (size_t)MPAD * DM * 2,
                 WS_A1 = WS_ACT, WS_QB = WS_A1 + (size_t)MPAD * DM * 2, WS_CBB = WS_QB + (size_t)MPAD * QW * 2, WS_UB = WS_CBB + (size_t)MPAD * CWID * 2,
                 WS_MIX = WS_UB + (size_t)MPAD * CWID * 2, WS_PART = WS_MIX + (size_t)MPAD * DM * 2, WS_H2B = WS_PART + (size_t)256 * 32 * 512 * 16, WS_END = WS_H2B + (size_t)MPAD * DM * 2;
static_assert(WS_PART - WS_ACT >= (size_t)MPAD * DFF * 2, "act overlay");
constexpr int SM_RS1 = 0, SM_RSQA = MPAD, SM_RSQC = 2 * MPAD, SM_RSQ1 = 3 * MPAD, SM_RSQ2 = 4 * MPAD, SM_ROPE = 5 * MPAD  , SM_FLAGS = 200000  ;

struct Params { const float* in[19]; float* out; unsigned char* ws; };

__device__ __forceinline__ unsigned cvt_pk_bf16(float lo, float hi) { unsigned r; asm volatile("v_cvt_pk_bf16_f32 %0, %1, %2" : "=v"(r) : "v"(lo), "v"(hi)); return r; }
__device__ __forceinline__ float bf_lo(unsigned w) { return __uint_as_float(w << 16); }
__device__ __forceinline__ float bf_hi(unsigned w) { return __uint_as_float(w & 0xffff0000u); }
__device__ __forceinline__ int my_tid(int wv) { int lane; asm volatile("v_mbcnt_lo_u32_b32 %0, -1, 0\n\tv_mbcnt_hi_u32_b32 %0, -1, %0" : "=v"(lane)); return wv * 64 + lane; }
__device__ __forceinline__ float wave_sum(float v) {
#pragma unroll
    for (int o = 32; o >= 1; o >>= 1) v += __shfl_xor(v, o);
    return v;
}

namespace pg8 {
constexpr int BM = 256, BK = 64, HALF = 128, HTB = HALF * BK * 2, STAGE_BYTES = 8 * HTB, NXCD = 8, WGM = 8;
__host__ __device__ __forceinline__ int lds_byte(int r, int c) { const int st = (r >> 4) * 2 + (c >> 5), rr = r & 15, cc = c & 31, ob = rr * 64 + cc * 2; return st * 1024 + (ob ^ (((ob >> 9) & 1) << 5)); }
__host__ __device__ __forceinline__ void stage_rc(int b, int& R, int& C) { const int st = b / 1024, sb = b % 1024, swz = sb ^ (((sb >> 9) & 1) << 5); R = (st >> 1) * 16 + swz / 64; C = (st & 1) * 32 + (swz % 64) / 2; }
__host__ __device__ __forceinline__ int perm32(int rho) { const int n = rho >> 4, i = rho & 15; return 8 * (i >> 2) + 4 * n + (i & 3); }
struct Unit { int pm, pn, kb, len, kind, seq; };
struct Gemm { const bf16_t* A; const bf16_t* Bt; int M, N, K; };
struct StaticOrder {
    int nM, nN, nt, j, x, base, nx, P;
    __device__ __forceinline__ void init(int M, int N, int K, int bid, int ksplit) {
        nM = M / BM; nN = N / BM; nt = K / BK; const int nwg = nM * nN;
        x = bid & 7; j = bid >> 3;
        const int q = nwg / NXCD, r = nwg % NXCD; nx = q + (x < r ? 1 : 0); base = x < r ? x * (q + 1) : r * (q + 1) + (x - r) * q;
        const int rem = nx & 31; P = 1;
        if (ksplit && rem > 0 && rem <= 8) { P = 32 / rem; if (P > 8) P = 8; }
    }
    __device__ __forceinline__ int piece_begin(int q) const { return 2 * ((q * (nt >> 1)) / P); }
    __device__ __forceinline__ bool next(int i, Unit& u) const {
        const int R = nx >> 5, rem = nx & 31;
        int o = i * 32 + j; u.kb = 0; u.len = nt; u.kind = 0; u.seq = i;
        if (i >= R) {
            if (i > R || j >= rem * P) return false;
            if (P > 1) { const int q = j % P; o = R * 32 + j / P; u.kb = piece_begin(q); u.len = piece_begin(q + 1) - u.kb; u.kind = (q == 0) ? 2 : 1; }
        }
        const int idx = base + o;
        const int nig = WGM * nN, gid = idx / nig, fm = gid * WGM, gsz = (nM - fm) < WGM ? (nM - fm) : WGM;
        u.pm = fm + ((idx % nig) % gsz); u.pn = (idx % nig) / gsz; return true;
    }
};

template <class Epi>
__device__ __forceinline__ void gemm_phase(LAS unsigned char* lds, const Gemm g, const StaticOrder& S, const Epi& E, int wv, f32x4* part, unsigned* flags) {
    int tid = my_tid(wv); asm volatile("" : "+v"(tid));
    const int wid = __builtin_amdgcn_readfirstlane(tid >> 6), lane = tid & 63, wr = wid >> 2, wc = wid & 3, fr = lane & 15, fq = lane >> 4;
    const int K = g.K;
    unsigned voffA[2];
#pragma unroll
    for (int i = 0; i < 2; ++i) voffA[i] = (unsigned)(tid * 16 + i * 8192);
#define voffB voffA
    const size_t kstep = (size_t)HTB;
    const size_t hstep = (size_t)(K / BK) * HTB;
    const size_t tstep = 2 * hstep;
    const unsigned ldsw = (unsigned)wid * 1024u;
    const int aoff = lds_byte(wr * 64 + fr, fq * 8), boff = lds_byte(wc * 32 + fr, fq * 8);
#define PG8_SA(b, h) (((b) * 2 + (h)) * HTB)
#define PG8_SB(b, h) ((4 + (b) * 2 + (h)) * HTB)
#define PG8_STAGE(bufoff, gbase, voff) do { _Pragma("unroll") for (int _i = 0; _i < 2; ++_i) \
        __builtin_amdgcn_global_load_lds((const unsigned*)((const char*)(gbase) + (voff)[_i]), (LAS unsigned*)(lds + (bufoff) + ldsw + _i * 8192), 16, 0, 0); } while (0)
#define PG8_LDA(dst, b, h) do { _Pragma("unroll") for (int m = 0; m < 4; ++m) _Pragma("unroll") for (int k = 0; k < 2; ++k) dst[m][k] = *(const LAS bf16x8*)(lds + PG8_SA(b, h) + aoff + m * 2048 + k * 1024); } while (0)
#define PG8_LDB(dst, b, h) do { _Pragma("unroll") for (int n = 0; n < 2; ++n) _Pragma("unroll") for (int k = 0; k < 2; ++k) dst[n][k] = *(const LAS bf16x8*)(lds + PG8_SB(b, h) + boff + n * 2048 + k * 1024); } while (0)
#define PG8_MMA(ai, bj, At, Bt) do { __builtin_amdgcn_s_setprio(1); _Pragma("unroll") for (int m = 0; m < 4; ++m) _Pragma("unroll") for (int n = 0; n < 2; ++n) _Pragma("unroll") for (int k = 0; k < 2; ++k) \
        acc[ai][bj][m][n] = __builtin_amdgcn_mfma_f32_16x16x32_bf16(Bt[n][k], At[m][k], acc[ai][bj][m][n], 0, 0, 0); __builtin_amdgcn_s_setprio(0); } while (0)
#define PG8_WAIT_V(n) asm volatile("s_waitcnt vmcnt(" #n ")" ::: "memory")
#define PG8_WAIT_L(n) asm volatile("s_waitcnt lgkmcnt(" #n ")" ::: "memory")
#define PG8_BAR __builtin_amdgcn_s_barrier()
#define PG8_SCHED __builtin_amdgcn_sched_barrier(0)
    Unit cur, nxt; int ui = 0;
    if (!S.next(0, cur)) return;
    f32x4 acc[2][2][4][2];
    E.init(acc, cur, wr, wc, fr, fq, cur.kind != 1);
    bf16x8 At[4][2], B0[2][2], B1[2][2];
    const __amdgpu_buffer_rsrc_t prsrc = __builtin_amdgcn_make_buffer_rsrc((void*)part, 0, 256 * 262144, 0x00020000);
    const char* cA = (const char*)g.A + (size_t)cur.pm * tstep + (size_t)cur.kb * kstep; const char* cB = (const char*)g.Bt + (size_t)cur.pn * tstep + (size_t)cur.kb * kstep;
    PG8_STAGE(PG8_SB(0, 0), cB, voffB); PG8_STAGE(PG8_SA(0, 0), cA, voffA); PG8_STAGE(PG8_SB(0, 1), cB + hstep, voffB); PG8_STAGE(PG8_SA(0, 1), cA + hstep, voffA);
    if (wr == 1) PG8_BAR;
    PG8_WAIT_V(4); PG8_BAR;
    PG8_STAGE(PG8_SB(1, 0), cB + kstep, voffB); PG8_STAGE(PG8_SA(1, 0), cA + kstep, voffA); PG8_STAGE(PG8_SB(1, 1), cB + hstep + kstep, voffB);
    PG8_WAIT_V(6); PG8_BAR;
    for (;;) {
        const bool has_next = S.next(ui + 1, nxt);
        const char* nA = has_next ? (const char*)g.A + (size_t)nxt.pm * tstep + (size_t)nxt.kb * kstep : cA; const char* nB = has_next ? (const char*)g.Bt + (size_t)nxt.pn * tstep + (size_t)nxt.kb * kstep : cB;
        const int nt = cur.len;
        int t = 0;
        do {
            const bool last = (t == nt - 2);
            const char* a1 = cA + (size_t)(t + 1) * kstep;
            const char* a2 = last ? nA : cA + (size_t)(t + 2) * kstep; const char* b2 = last ? nB : cB + (size_t)(t + 2) * kstep;
            const char* a3 = a2 + kstep; const char* b3 = b2 + kstep;
            PG8_LDB(B0, 0, 0); PG8_SCHED; PG8_LDA(At, 0, 0); PG8_STAGE(PG8_SA(1, 1), a1 + hstep, voffA);
            PG8_WAIT_L(8); PG8_BAR; PG8_WAIT_L(0); PG8_MMA(0, 0, At, B0); PG8_BAR; PG8_SCHED;
            PG8_LDB(B1, 0, 1); PG8_STAGE(PG8_SB(0, 0), b2, voffB);
            PG8_BAR; PG8_WAIT_L(0); PG8_MMA(0, 1, At, B1); PG8_BAR;
            PG8_LDA(At, 0, 1); PG8_STAGE(PG8_SA(0, 0), a2, voffA);
            PG8_BAR; PG8_WAIT_L(0); PG8_MMA(1, 0, At, B0); PG8_BAR; PG8_SCHED;
            PG8_STAGE(PG8_SB(0, 1), b2 + hstep, voffB);
            PG8_WAIT_V(6); PG8_BAR; PG8_MMA(1, 1, At, B1); PG8_BAR;
            PG8_LDB(B0, 1, 0); PG8_SCHED; PG8_LDA(At, 1, 0); PG8_STAGE(PG8_SA(0, 1), a2 + hstep, voffA);
            PG8_WAIT_L(8); PG8_BAR; PG8_WAIT_L(0); PG8_MMA(0, 0, At, B0); PG8_BAR; PG8_SCHED;
            PG8_LDB(B1, 1, 1); PG8_STAGE(PG8_SB(1, 0), b3, voffB);
            PG8_BAR; PG8_WAIT_L(0); PG8_MMA(0, 1, At, B1); PG8_BAR;
            PG8_LDA(At, 1, 1); PG8_STAGE(PG8_SA(1, 0), a3, voffA);
            PG8_BAR; PG8_WAIT_L(0); PG8_MMA(1, 0, At, B0); PG8_BAR; PG8_SCHED;
            PG8_STAGE(PG8_SB(1, 1), b3 + hstep, voffB);
            PG8_WAIT_V(6); PG8_BAR; PG8_MMA(1, 1, At, B1); PG8_BAR;
            t += 2;
        } while (t < nt);
        { int efr = fr, efq = fq, etid = tid; asm volatile("" : "+v"(efr), "+v"(efq), "+v"(etid));
          if (cur.kind == 1) {
              const unsigned off = (unsigned)blockIdx.x * 262144u + (unsigned)etid * 16u;
#pragma unroll
              for (int a = 0; a < 2; ++a)
#pragma unroll
                  for (int b = 0; b < 2; ++b)
#pragma unroll
                      for (int m = 0; m < 4; ++m)
#pragma unroll
                          for (int n = 0; n < 2; ++n) __builtin_amdgcn_raw_buffer_store_b128(__builtin_bit_cast(u32x4, acc[a][b][m][n]), prsrc, off, (((a * 2 + b) * 4 + m) * 2 + n) * 8192, 16);
              asm volatile("s_waitcnt vmcnt(0)" ::: "memory");
              if ((etid & 63) == 0) __hip_atomic_store(flags + blockIdx.x * 8 + wid, 1u, __ATOMIC_RELAXED, __HIP_MEMORY_SCOPE_AGENT);
          } else if (cur.kind == 0) E(acc, cur, wr, wc, efr, efq);
        }
        if (!has_next) break;
        { int efr = fr, efq = fq; asm volatile("" : "+v"(efr), "+v"(efq)); E.init(acc, nxt, wr, wc, efr, efq, nxt.kind != 1); }
        cur = nxt; cA = nA; cB = nB; ++ui;
    }
    PG8_WAIT_V(0);
    if (wr == 0) PG8_BAR;
    PG8_BAR;
    if (cur.kind == 2) {
        int efr = fr, efq = fq, etid = tid; asm volatile("" : "+v"(efr), "+v"(efq), "+v"(etid));
        for (int q = 1; q < S.P; ++q) {
            const int pb = (S.j + q) * 8 + S.x;
            while (__hip_atomic_load(flags + pb * 8 + wid, __ATOMIC_RELAXED, __HIP_MEMORY_SCOPE_AGENT) == 0u) __builtin_amdgcn_s_sleep(2);
            const unsigned off = (unsigned)pb * 262144u + (unsigned)etid * 16u;
#pragma unroll
            for (int a = 0; a < 2; ++a)
#pragma unroll
                for (int b = 0; b < 2; ++b) {
                    f32x4 t[8];
#pragma unroll
                    for (int m = 0; m < 4; ++m)
#pragma unroll
                        for (int n = 0; n < 2; ++n) t[m * 2 + n] = __builtin_bit_cast(f32x4, __builtin_amdgcn_raw_buffer_load_b128(prsrc, off, (((a * 2 + b) * 4 + m) * 2 + n) * 8192, 16));
#pragma unroll
                    for (int m = 0; m < 4; ++m)
#pragma unroll
                        for (int n = 0; n < 2; ++n) acc[a][b][m][n] += t[m * 2 + n];
                    __builtin_amdgcn_sched_barrier(0);
                }
        }
        E(acc, cur, wr, wc, efr, efq);
    }
#undef voffB
#undef PG8_SA
#undef PG8_SB
#undef PG8_STAGE
#undef PG8_LDA
#undef PG8_LDB
#undef PG8_MMA
#undef PG8_WAIT_V
#undef PG8_WAIT_L
#undef PG8_BAR
#undef PG8_SCHED
}
}
using pg8::Unit;
__device__ __forceinline__ size_t tiled_off(int row, int k, int KT) { return ((size_t)((row >> 7) * KT + (k >> 6)) << 14) + (size_t)pg8::lds_byte(row & 127, k & 63); }
__device__ __forceinline__ int inv_perm32(int w) { return (((w >> 2) & 1) << 4) | ((w >> 3) << 2) | (w & 3); }

__device__ __forceinline__ void unpack8(const u32x4 w, float (&f)[8]) { f[0] = bf_lo(w.x); f[1] = bf_hi(w.x); f[2] = bf_lo(w.y); f[3] = bf_hi(w.y); f[4] = bf_lo(w.z); f[5] = bf_hi(w.z); f[6] = bf_lo(w.w); f[7] = bf_hi(w.w); }
__device__ __forceinline__ void load8f(const float* s, float (&f)[8]) { const f32x4 a = *(const f32x4*)s, b = *(const f32x4*)(s + 4); f[0] = a[0]; f[1] = a[1]; f[2] = a[2]; f[3] = a[3]; f[4] = b[0]; f[5] = b[1]; f[6] = b[2]; f[7] = b[3]; }

typedef f32x4 Acc[2][2][4][2];

struct EpiIn {
    static constexpr bool MID = false;
    const float* sm; bf16_t *Qb, *Kp, *Ks, *Vtp, *Vts, *CBb, *Ub; float* out;
    __device__ __forceinline__ void init(Acc& acc, const Unit& u, int wr, int wc, int fr, int fq, bool first) const {
#pragma unroll
        for (int a = 0; a < 2; ++a)
#pragma unroll
            for (int b = 0; b < 2; ++b)
#pragma unroll
                for (int m = 0; m < 4; ++m)
#pragma unroll
                    for (int n = 0; n < 2; ++n) acc[a][b][m][n] = (f32x4){0.f, 0.f, 0.f, 0.f};
    }
    __device__ __forceinline__ void operator()(const Acc& acc, const Unit& u, int wr, int wc, int fr, int fq) const {
        const int pn = u.pn;
        const int lane16 = 16;
        float rsv[2][4];
#pragma unroll
        for (int ai = 0; ai < 2; ++ai)
#pragma unroll
            for (int m = 0; m < 4; ++m) rsv[ai][m] = sm[SM_RS1 + u.pm * 256 + ai * 128 + wr * 64 + m * 16 + fr];
#pragma unroll
        for (int q = 0; q < 4; ++q) asm volatile("" :: "v"(rsv[0][q]), "v"(rsv[1][q]));
#pragma unroll
        for (int aim = 0; aim < 4; ++aim) {
            const int ai = aim >> 1;
            f32x4 rc0[2], rc1[2], rs0[2], rs1[2];
#pragma unroll
            for (int mm = 0; mm < 2; ++mm) { rc0[mm] = (f32x4){1.f, 1.f, 1.f, 1.f}; rc1[mm] = rc0[mm]; rs0[mm] = (f32x4){0.f, 0.f, 0.f, 0.f}; rs1[mm] = rs0[mm]; }
            if (pn < 9 && ((wc & 1) == 0) && fq < 2) {
#pragma unroll
                for (int mm = 0; mm < 2; ++mm) { const float* rt = sm + SM_ROPE + (size_t)(u.pm * 256 + ai * 128 + wr * 64 + ((aim & 1) * 2 + mm) * 16 + fr) * 16;
                    rc0[mm] = *(const f32x4*)rt; rc1[mm] = *(const f32x4*)(rt + 4); rs0[mm] = *(const f32x4*)(rt + 8); rs1[mm] = *(const f32x4*)(rt + 12); }
            }
            if (pn < 9) {
#pragma unroll
                for (int mm = 0; mm < 2; ++mm)
#pragma unroll
                    for (int q = 0; q < 4; ++q) asm volatile("" :: "v"(rc0[mm][q]), "v"(rc1[mm][q]), "v"(rs0[mm][q]), "v"(rs1[mm][q]));
            }
#pragma unroll
            for (int mm = 0; mm < 2; ++mm) {
                const int m = (aim & 1) * 2 + mm;
                const int row = u.pm * 256 + ai * 128 + wr * 64 + m * 16 + fr;
                const float rs = rsv[ai][m];
                const bool is_p = row < LP, is_s = (row >= LP) && (row < MR);
                const int sr = row - LP, ss = sr >> 2, st = sr & 3;
                if (pn < 9) {
                    const bool ropew = ((wc & 1) == 0);
                    f32x4 c0 = rc0[mm], c1 = rc1[mm], s0 = rs0[mm], s1 = rs1[mm];
                    if (fq == 0) { s0 = -s0; s1 = -s1; }
#pragma unroll
                    for (int bj = 0; bj < 2; ++bj) {
                        f32x4 v0 = acc[ai][bj][m][0] * rs, v1 = acc[ai][bj][m][1] * rs;
                        if (ropew) {
                            f32x4 p0, p1;
#pragma unroll
                            for (int j = 0; j < 4; ++j) { p0[j] = __shfl_xor(v0[j], lane16); p1[j] = __shfl_xor(v1[j], lane16); }
                            v0 = v0 * c0 + p0 * s0; v1 = v1 * c1 + p1 * s1;
                        }
                        u32x4 w; w.x = cvt_pk_bf16(v0[0], v0[1]); w.y = cvt_pk_bf16(v0[2], v0[3]); w.z = cvt_pk_bf16(v1[0], v1[1]); w.w = cvt_pk_bf16(v1[2], v1[3]);
                        const int cl = bj * 128 + wc * 32 + 8 * fq;
                        if (pn < 8) { *(u32x4*)(Qb + (size_t)row * QW + pn * 256 + cl) = w; }
                        else if (is_p) {
                            *(u32x4*)(Kp + (size_t)row * 256 + cl) = w;
                            if (row >= LP - 128) { float* o = out + OFF_NKP + (size_t)(row - (LP - 128)) * 256 + cl; *(f32x4*)o = v0; *(f32x4*)(o + 4) = v1; }
                        } else if (is_s) {
                            *(u32x4*)(Ks + ((size_t)ss * 132 + 128 + st) * 256 + cl) = w;
                            float* o = out + OFF_NKS + ((size_t)ss * 128 + 124 + st) * 256 + cl; *(f32x4*)o = v0; *(f32x4*)(o + 4) = v1;
                        }
                    }
                } else if (pn == 9) {
#pragma unroll
                    for (int bj = 0; bj < 2; ++bj) {
                        const f32x4 v0 = acc[ai][bj][m][0] * rs, v1 = acc[ai][bj][m][1] * rs;
                        const int cl = bj * 128 + wc * 32 + 8 * fq;
                        const unsigned w0 = cvt_pk_bf16(v0[0], v0[1]), w1 = cvt_pk_bf16(v0[2], v0[3]), w2 = cvt_pk_bf16(v1[0], v1[1]), w3 = cvt_pk_bf16(v1[2], v1[3]);
                        if (is_p) {
                            bf16_t* d = Vtp + (size_t)cl * LP + row;
                            d[0] = (bf16_t)w0; d[LP] = (bf16_t)(w0 >> 16); d[2 * LP] = (bf16_t)w1; d[3 * LP] = (bf16_t)(w1 >> 16);
                            d[4 * LP] = (bf16_t)w2; d[5 * LP] = (bf16_t)(w2 >> 16); d[6 * LP] = (bf16_t)w3; d[7 * LP] = (bf16_t)(w3 >> 16);
                            if (row >= LP - 128) { float* o = out + OFF_NVP + (size_t)(row - (LP - 128)) * 256 + cl; *(f32x4*)o = v0; *(f32x4*)(o + 4) = v1; }
                        } else if (is_s) {
                            bf16_t* d = Vts + ((size_t)ss * 256 + cl) * 136 + 128 + st;
                            d[0] = (bf16_t)w0; d[136] = (bf16_t)(w0 >> 16); d[2 * 136] = (bf16_t)w1; d[3 * 136] = (bf16_t)(w1 >> 16);
                            d[4 * 136] = (bf16_t)w2; d[5 * 136] = (bf16_t)(w2 >> 16); d[6 * 136] = (bf16_t)w3; d[7 * 136] = (bf16_t)(w3 >> 16);
                            float* o = out + OFF_NVS + ((size_t)ss * 128 + 124 + st) * 256 + cl; *(f32x4*)o = v0; *(f32x4*)(o + 4) = v1;
                        }
                    }
                } else if (pn < 18) {
#pragma unroll
                    for (int bj = 0; bj < 2; ++bj) {
                        const f32x4 v0 = acc[ai][bj][m][0] * rs, v1 = acc[ai][bj][m][1] * rs;
                        u32x4 w; w.x = cvt_pk_bf16(v0[0], v0[1]); w.y = cvt_pk_bf16(v0[2], v0[3]); w.z = cvt_pk_bf16(v1[0], v1[1]); w.w = cvt_pk_bf16(v1[2], v1[3]);
                        *(u32x4*)(CBb + (size_t)row * CWID + (pn - 10) * 256 + bj * 128 + wc * 32 + 8 * fq) = w;
                    }
                } else {
                    const float r2 = rs * rs;
                    const f32x4 v0 = acc[ai][0][m][0] * acc[ai][1][m][0] * r2, v1 = acc[ai][0][m][1] * acc[ai][1][m][1] * r2;
                    const int j0 = (pn - 18) * 128 + wc * 32 + 8 * fq;
                    u32x4 w; w.x = cvt_pk_bf16(v0[0], v0[1]); w.y = cvt_pk_bf16(v0[2], v0[3]); w.z = cvt_pk_bf16(v1[0], v1[1]); w.w = cvt_pk_bf16(v1[2], v1[3]);
                    *(u32x4*)(Ub + (size_t)row * CWID + j0) = w;
                    if (is_p && row >= LP - 2) { float* o = out + OFF_NCP + (size_t)(row - (LP - 2)) * CWID + j0; *(f32x4*)o = v0; *(f32x4*)(o + 4) = v1; }
                    if (is_s && st >= 2) { float* o = out + OFF_NCS + ((size_t)ss * 2 + (st - 2)) * CWID + j0; *(f32x4*)o = v0; *(f32x4*)(o + 4) = v1; }
                }
            }
        }
    }
};

struct EpiOut {
    static constexpr bool MID = false;
    float* sm; const float *xp, *xs, *meta; bf16_t* H1b;
    __device__ __forceinline__ void init(Acc& acc, const Unit& u, int wr, int wc, int fr, int fq, bool first) const {
#pragma unroll
        for (int ai = 0; ai < 2; ++ai)
#pragma unroll
            for (int m = 0; m < 4; ++m) {
                const int row = u.pm * 256 + ai * 128 + wr * 64 + m * 16 + fr;
                const float* hrow = row < 16 ? meta + (size_t)row * DM : (row < LP ? xp + (size_t)(row - 16) * DM : (row < MR ? xs + (size_t)(row - LP) * DM : nullptr));
#pragma unroll
                for (int bj = 0; bj < 2; ++bj) {
                    const int col = u.pn * 256 + bj * 128 + wc * 32 + 8 * fq;
                    f32x4 h0 = {0.f, 0.f, 0.f, 0.f}, h1 = h0;
                    if (first && hrow) { h0 = *(const f32x4*)(hrow + col); h1 = *(const f32x4*)(hrow + col + 4); }
                    acc[ai][bj][m][0] = h0; acc[ai][bj][m][1] = h1;
                }
            }
    }
    __device__ __forceinline__ void operator()(const Acc& acc, const Unit& u, int wr, int wc, int fr, int fq) const {
#pragma unroll
        for (int ai = 0; ai < 2; ++ai)
#pragma unroll
            for (int m = 0; m < 4; ++m) {
                const int row = u.pm * 256 + ai * 128 + wr * 64 + m * 16 + fr;
                float ssq = 0.f;
#pragma unroll
                for (int bj = 0; bj < 2; ++bj) {
                    const int col = u.pn * 256 + bj * 128 + wc * 32 + 8 * fq;
                    const f32x4 v0 = acc[ai][bj][m][0], v1 = acc[ai][bj][m][1];
                    u32x4 w; w.x = cvt_pk_bf16(v0[0], v0[1]); w.y = cvt_pk_bf16(v0[2], v0[3]); w.z = cvt_pk_bf16(v1[0], v1[1]); w.w = cvt_pk_bf16(v1[2], v1[3]);
                    if (row < LP) { const int t = row / 254, loc = row - 254 * t;
                        *(u32x4*)((char*)H1b + tiled_off(256 * t + loc, col, DM / 64)) = w;
                        if (loc < 2 && t > 0) *(u32x4*)((char*)H1b + tiled_off(256 * t - 2 + loc, col, DM / 64)) = w;
                    } else if (row < MR) *(u32x4*)((char*)H1b + tiled_off(8448 + (row - LP), col, DM / 64)) = w;
                    ssq += (v0[0] * v0[0] + v0[1] * v0[1]) + (v0[2] * v0[2] + v0[3] * v0[3]) + (v1[0] * v1[0] + v1[1] * v1[1]) + (v1[2] * v1[2] + v1[3] * v1[3]);
                }
                ssq += __shfl_xor(ssq, 16); ssq += __shfl_xor(ssq, 32);
                if (fq == 0) atomicAdd(sm + SM_RSQ1 + row, ssq);
            }
    }
};

constexpr int DPP_ROR1 = 0x121, DPP_ROR2 = 0x122;
__device__ __forceinline__ float dpp_ror1(float v) { return __builtin_bit_cast(float, __builtin_amdgcn_update_dpp(0, __builtin_bit_cast(int, v), DPP_ROR1, 0xf, 0xf, false)); }
__device__ __forceinline__ float dpp_shr1_old(float old, float v) { return __builtin_bit_cast(float, __builtin_amdgcn_update_dpp(__builtin_bit_cast(int, old), __builtin_bit_cast(int, v), 0x111, 0xf, 0xf, false)); }
__device__ __forceinline__ float dpp_shr2_old(float old, float v) { return __builtin_bit_cast(float, __builtin_amdgcn_update_dpp(__builtin_bit_cast(int, old), __builtin_bit_cast(int, v), 0x112, 0xf, 0xf, false)); }
__device__ __forceinline__ float dpp_ror2(float v) { return __builtin_bit_cast(float, __builtin_amdgcn_update_dpp(0, __builtin_bit_cast(int, v), DPP_ROR2, 0xf, 0xf, false)); }
struct EpiGU {
    static constexpr bool MID = false;
    const float* sm; bf16_t* Act; float* out; const float* fw; const float* stf; LAS float* X;
    LAS unsigned char* pre;
    __device__ __forceinline__ void init(Acc& acc, const Unit& u, int wr, int wc, int fr, int fq, bool first) const {
        if (wr == 0 && wc == 0) {
            const int lane = fq * 16 + fr;
            LAS unsigned char* b = pre + (u.seq & 1) * 2560;
            const float* rsrc = sm + SM_RSQ1 + (u.pm >= 33 ? LP + (u.pm - 33) * 256 : u.pm * 254) + lane;
#pragma unroll
            for (int i = 0; i < 4; ++i) __builtin_amdgcn_global_load_lds((const unsigned*)(rsrc + 64 * i), (LAS unsigned*)(b + 256 * i), 4, 0, 0);
#pragma unroll
            for (int i = 0; i < 6; ++i) __builtin_amdgcn_global_load_lds((const unsigned*)(fw + (size_t)(i >> 1) * DFF + u.pn * 128 + (i & 1) * 64 + lane), (LAS unsigned*)(b + 1024 + 256 * i), 4, 0, 0);
        }
#pragma unroll
        for (int a = 0; a < 2; ++a)
#pragma unroll
            for (int b = 0; b < 2; ++b)
#pragma unroll
                for (int m = 0; m < 4; ++m)
#pragma unroll
                    for (int n = 0; n < 2; ++n) acc[a][b][m][n] = (f32x4){0.f, 0.f, 0.f, 0.f};
    }
    __device__ __forceinline__ void operator()(const Acc& acc, const Unit& u, int wr, int wc, int fr, int fq) const {
        if (u.pm >= 33) run<true>(acc, u, wr, wc, fr, fq); else run<false>(acc, u, wr, wc, fr, fq);
    }
    template <bool samp>
    __device__ __forceinline__ void run(const Acc& acc, const Unit& u, int wr, int wc, int fr, int fq) const {
        const int rbase = samp ? LP + (u.pm - 33) * 256 : u.pm * 254;
        float rsv[2][4];
        const int j0 = u.pn * 128 + wc * 32 + 8 * fq;
        float w0[8], w1[8], w2[8];
        const LAS float* pb = (const LAS float*)(pre + (u.seq & 1) * 2560);
#pragma unroll
        for (int ai = 0; ai < 2; ++ai)
#pragma unroll
            for (int m = 0; m < 4; ++m) rsv[ai][m] = __builtin_amdgcn_rsqf(pb[ai * 128 + wr * 64 + m * 16 + fr] * (1.0f / 4096.0f) + EPS);
        { const LAS float* wp = pb + 256 + wc * 32 + 8 * fq;
          const f32x4 a0 = *(const LAS f32x4*)wp, a1 = *(const LAS f32x4*)(wp + 4), b0 = *(const LAS f32x4*)(wp + 128), b1 = *(const LAS f32x4*)(wp + 132), c0 = *(const LAS f32x4*)(wp + 256), c1 = *(const LAS f32x4*)(wp + 260);
#pragma unroll
          for (int q = 0; q < 4; ++q) { w0[q] = a0[q]; w0[q + 4] = a1[q]; w1[q] = b0[q]; w1[q + 4] = b1[q]; w2[q] = c0[q]; w2[q + 4] = c1[q]; } }
#pragma unroll
        for (int q = 0; q < 8; ++q) asm volatile("" :: "v"(w0[q]), "v"(w1[q]), "v"(w2[q]));
#pragma unroll
        for (int ai = 0; ai < 2; ++ai) {
            if (ai == 1 && wr == 1) continue;
            const float rs = rsv[ai][3];
            const f32x4 g0 = acc[ai][0][3][0] * rs, g1 = acc[ai][0][3][1] * rs;
            if (fr >= 14) { LAS float* x = X + ((wc * 3 + (wr == 0 ? ai : 2)) * 2 + (fr - 14)) * 32 + 8 * fq; *(LAS f32x4*)x = g0; *(LAS f32x4*)(x + 4) = g1; }
        }
        asm volatile("s_waitcnt lgkmcnt(0)" ::: "memory"); __builtin_amdgcn_s_barrier(); asm volatile("" ::: "memory"); __builtin_amdgcn_s_barrier(); asm volatile("" ::: "memory");
#pragma unroll
        for (int ai = 0; ai < 2; ++ai) {
            float pg[8];
#pragma unroll
            for (int mp = 0; mp < 4; ++mp) {
            float h2[1][8], h1[1][8];
            if (samp) {
                { const int li = ai * 128 + wr * 64 + mp * 16 + fr, t4 = li & 3, sq = ((u.pm - 33) * 256 + li) >> 2;
                    load8f(stf + ((size_t)sq * 2 + (t4 & 1)) * DFF + j0, h2[0]); load8f(stf + ((size_t)sq * 2 + 1) * DFF + j0, h1[0]); }
#pragma unroll
                for (int q = 0; q < 8; ++q) asm volatile("" :: "v"(h2[0][q]), "v"(h1[0][q]));
            }
#pragma unroll
            for (int mm = 0; mm < 1; ++mm) {
                const int m = mp;
                const int li = ai * 128 + wr * 64 + m * 16 + fr, row = rbase + li;
                const float rs = rsv[ai][m];
                const f32x4 g0 = acc[ai][0][m][0] * rs, g1 = acc[ai][0][m][1] * rs, u0 = acc[ai][1][m][0] * rs, u1 = acc[ai][1][m][1] * rs;
                float g[8] = {g0[0], g0[1], g0[2], g0[3], g1[0], g1[1], g1[2], g1[3]};
                float up[8] = {u0[0], u0[1], u0[2], u0[3], u1[0], u1[1], u1[2], u1[3]};
                float r1[8], r2[8];
                if (m > 0) {
#pragma unroll
                    for (int q = 0; q < 8; ++q) { r1[q] = dpp_shr1_old(dpp_ror1(pg[q]), g[q]); r2[q] = dpp_shr2_old(dpp_ror2(pg[q]), g[q]); }
                } else {
                    float xa[8], xb[8];
                    if (ai == 0 && wr == 0) {
#pragma unroll
                        for (int q = 0; q < 8; ++q) { xa[q] = 0.f; xb[q] = 0.f; }
                    } else {
                        const int src = (ai == 0) ? 0 : (wr == 0 ? 2 : 1);
                        const LAS float* x = X + ((wc * 3 + src) * 2) * 32 + 8 * fq;
                        const f32x4 a0 = *(const LAS f32x4*)x, a1 = *(const LAS f32x4*)(x + 4), b0 = *(const LAS f32x4*)(x + 32), b1 = *(const LAS f32x4*)(x + 36);
#pragma unroll
                        for (int q = 0; q < 4; ++q) { xa[q] = a0[q]; xa[q + 4] = a1[q]; xb[q] = b0[q]; xb[q + 4] = b1[q]; }
                    }
#pragma unroll
                    for (int q = 0; q < 8; ++q) { r1[q] = dpp_shr1_old(xb[q], g[q]); r2[q] = dpp_shr2_old(fr == 0 ? xa[q] : xb[q], g[q]); }
                }
                if (samp) {
                    const int t4 = li & 3;
#pragma unroll
                    for (int q = 0; q < 8; ++q) { r2[q] = t4 < 2 ? h2[mm][q] : r2[q]; r1[q] = t4 < 1 ? h1[mm][q] : r1[q]; }
                }
                float o[8];
#pragma unroll
                for (int q = 0; q < 8; ++q) { const float gc = r2[q] * w0[q] + r1[q] * w1[q] + g[q] * w2[q]; o[q] = gc * __builtin_amdgcn_rcpf(1.0f + __expf(-gc)) * up[q]; pg[q] = g[q]; }
                const bool valid = samp ? true : ((li >= 2 || u.pm == 0) && row < LP);
                if (valid) {
                    u32x4 w; w.x = cvt_pk_bf16(o[0], o[1]); w.y = cvt_pk_bf16(o[2], o[3]); w.z = cvt_pk_bf16(o[4], o[5]); w.w = cvt_pk_bf16(o[6], o[7]);
                    *(u32x4*)((char*)Act + tiled_off(row, j0, DFF / 64)) = w;
                    if (!samp && row >= LP - 2) { float* op = out + OFF_NFP + (size_t)(row - (LP - 2)) * DFF + j0; *(f32x4*)op = g0; *(f32x4*)(op + 4) = g1; }
                    if (samp && (li & 3) >= 2) { const int sr = row - LP; float* op = out + OFF_NFS + ((size_t)(sr >> 2) * 2 + ((sr & 3) - 2)) * DFF + j0; *(f32x4*)op = g0; *(f32x4*)(op + 4) = g1; }
                }
            }
            }
        }
    }
};

struct EpiDown {
    static constexpr bool MID = false;
    float* sm; const bf16_t* H1b; bf16_t* H2b;
    __device__ __forceinline__ void init(Acc& acc, const Unit& u, int wr, int wc, int fr, int fq, bool first) const {
#pragma unroll
        for (int ai = 0; ai < 2; ++ai)
#pragma unroll
            for (int m = 0; m < 4; ++m) {
                const int row = u.pm * 256 + ai * 128 + wr * 64 + m * 16 + fr;
#pragma unroll
                for (int bj = 0; bj < 2; ++bj) {
                    const int col = u.pn * 256 + bj * 128 + wc * 32 + 8 * fq;
                    const int t = row / 254, er = row < LP ? 2 * t + row : 8448 + (row - LP);
                    f32x4 h0 = {0.f, 0.f, 0.f, 0.f}, h1 = h0;
                    if (first && row < MR) { const u32x4 w = *(const u32x4*)((const char*)H1b + tiled_off(er, col, DM / 64));
                        h0 = (f32x4){bf_lo(w.x), bf_hi(w.x), bf_lo(w.y), bf_hi(w.y)}; h1 = (f32x4){bf_lo(w.z), bf_hi(w.z), bf_lo(w.w), bf_hi(w.w)}; }
                    acc[ai][bj][m][0] = h0; acc[ai][bj][m][1] = h1;
                }
            }
    }
    __device__ __forceinline__ void operator()(const Acc& acc, const Unit& u, int wr, int wc, int fr, int fq) const {
#pragma unroll
        for (int ai = 0; ai < 2; ++ai)
#pragma unroll
            for (int m = 0; m < 4; ++m) {
                const int row = u.pm * 256 + ai * 128 + wr * 64 + m * 16 + fr;
                const bool orow = row >= 16 && row < MR;
                float ssq = 0.f;
                if (orow) {
#pragma unroll
                    for (int bj = 0; bj < 2; ++bj) {
                        const int col = u.pn * 256 + bj * 128 + wc * 32 + 8 * fq;
                        const f32x4 v0 = acc[ai][bj][m][0], v1 = acc[ai][bj][m][1];
                        u32x4 w; w.x = cvt_pk_bf16(v0[0], v0[1]); w.y = cvt_pk_bf16(v0[2], v0[3]); w.z = cvt_pk_bf16(v1[0], v1[1]); w.w = cvt_pk_bf16(v1[2], v1[3]);
                        *(u32x4*)(H2b + (size_t)row * DM + col) = w;
                        ssq += (v0[0] * v0[0] + v0[1] * v0[1]) + (v0[2] * v0[2] + v0[3] * v0[3]) + (v1[0] * v1[0] + v1[1] * v1[1]) + (v1[2] * v1[2] + v1[3] * v1[3]);
                    }
                }
                ssq += __shfl_xor(ssq, 16); ssq += __shfl_xor(ssq, 32);
                if (fq == 0 && orow) atomicAdd(sm + SM_RSQ2 + row, ssq);
            }
    }
};

struct TileJob { const float* src; const float* g; bf16_t* dst; int N, Kd, k0, n0, orow; };
__device__ __forceinline__ TileJob decode_tile(const Params& p, int id) {
    TileJob j;
    if (id < 2176) { const int kt = id / 68, nt = id % 68; j.src = p.in[8]; j.N = INW; j.Kd = DM; j.k0 = kt * 128; j.n0 = nt * 128; j.g = p.in[7] + j.k0; j.dst = (bf16_t*)(p.ws + WS_W1);
        if (j.n0 < 4608) j.orow = j.n0; else if (j.n0 < 6656) j.orow = 4608 + ((j.n0 - 4608) >> 7) * 256; else j.orow = 4608 + ((j.n0 - 6656) >> 7) * 256 + 128; }
    else if (id < 3200) { id -= 2176; const int kt = id >> 5, nt = id & 31; j.src = p.in[13]; j.N = DM; j.Kd = DM; j.k0 = kt * 128; j.n0 = nt * 128; j.g = (j.k0 < 2048) ? p.in[11] + j.k0 : p.in[12] + (j.k0 - 2048);
        j.dst = (bf16_t*)(p.ws + WS_W2); j.orow = j.n0; }
    else if (id < 8704) { id -= 3200; const int kt = id / 172, nt = id % 172; j.src = p.in[15]; j.N = 2 * DFF; j.Kd = DM; j.k0 = kt * 128; j.n0 = nt * 128; j.g = p.in[14] + j.k0; j.dst = (bf16_t*)(p.ws + WS_W3);
        j.orow = (j.n0 < DFF) ? (j.n0 >> 7) * 256 : ((j.n0 - DFF) >> 7) * 256 + 128; }
    else { id -= 8704; const int kt = id >> 5, nt = id & 31; j.src = p.in[17]; j.N = DM; j.Kd = DFF; j.k0 = kt * 128; j.n0 = nt * 128; j.g = nullptr; j.dst = (bf16_t*)(p.ws + WS_W4); j.orow = j.n0; }
    return j;
}
constexpr int N_WTILES = 2176 + 1024 + 5504 + 2752;

__device__ __forceinline__ void tile_load(const TileJob& j, int tid, f32x4 (&r)[8]) {
    const int nq = tid & 31, kp = tid >> 5;
#pragma unroll
    for (int ps = 0; ps < 4; ++ps) {
        const int kpp = kp + 16 * ps;
        const float* s = j.src + (size_t)(j.k0 + 2 * kpp) * j.N + j.n0 + 4 * nq;
        r[2 * ps] = __builtin_nontemporal_load((const f32x4*)s);
        r[2 * ps + 1] = __builtin_nontemporal_load((const f32x4*)(s + j.N));
    }
}
__device__ __forceinline__ void tile_store(const TileJob& j, int tid, const f32x4 (&r)[8], LAS unsigned* T) {
    const int nq = tid & 31, kp = tid >> 5;
#pragma unroll
    for (int ps = 0; ps < 4; ++ps) {
        const int kpp = kp + 16 * ps;
        float g0 = 1.f, g1 = 1.f;
        if (j.g) { g0 = j.g[2 * kpp]; g1 = j.g[2 * kpp + 1]; }
#pragma unroll
        for (int i = 0; i < 4; ++i) T[(4 * nq + i) * 65 + kpp] = cvt_pk_bf16(r[2 * ps][i] * g0, r[2 * ps + 1][i] * g1);
    }
    __syncthreads();
    const int n = tid >> 2, kq = tid & 3;
    u32x4 w[4];
#pragma unroll
    for (int q = 0; q < 4; ++q)
#pragma unroll
        for (int i = 0; i < 4; ++i) w[q][i] = T[n * 65 + 16 * kq + 4 * q + i];
    const int slot = (n & ~31) | inv_perm32(n & 31);
    char* d = (char*)j.dst + ((size_t)((j.orow >> 7) * (j.Kd >> 6) + (j.k0 >> 6) + (kq >> 1)) << 14);
#pragma unroll
    for (int q = 0; q < 4; ++q) *(u32x4*)(d + pg8::lds_byte(slot, 32 * (kq & 1) + 8 * q)) = w[q];
    __syncthreads();
}

__device__ __forceinline__ void phase0(const Params& p, LAS unsigned char* lds, int wv) {
    int tid = my_tid(wv); asm volatile("" : "+v"(tid));
    const int lane = tid & 63, wid = tid >> 6;
    const int gthreads = gridDim.x * 512, gtid = blockIdx.x * 512 + tid;
    const int gwaves = gridDim.x * 8, gwave = blockIdx.x * 8 + wid;
    float* sm = (float*)(p.ws + WS_SM);
    {
        bf16_t* A1 = (bf16_t*)(p.ws + WS_A1);
        for (int row = gwave; row < MPAD; row += gwaves) {
            const float* src = row < 16 ? p.in[6] + (size_t)row * DM : (row < LP ? p.in[0] + (size_t)(row - 16) * DM : (row < MR ? p.in[1] + (size_t)(row - LP) * DM : nullptr));
            float ss = 0.f;
#pragma unroll 4
            for (int it = 0; it < 16; ++it) {
                f32x4 v = {0.f, 0.f, 0.f, 0.f};
                if (src) v = *(const f32x4*)(src + it * 256 + lane * 4);
                ss += (v[0] * v[0] + v[1] * v[1]) + (v[2] * v[2] + v[3] * v[3]);
                u32x2 w; w.x = cvt_pk_bf16(v[0], v[1]); w.y = cvt_pk_bf16(v[2], v[3]);
                *(u32x2*)((char*)A1 + tiled_off(row, it * 256 + lane * 4, DM / 64)) = w;
            }
            ss = wave_sum(ss);
            if (lane == 0) { sm[SM_RS1 + row] = __builtin_amdgcn_rsqf(ss * (1.0f / 4096.0f) + EPS); sm[SM_RSQA + row] = 0.f; sm[SM_RSQC + row] = 0.f; sm[SM_RSQ1 + row] = 0.f; sm[SM_RSQ2 + row] = 0.f; }
            if (lane < 8) {
                const float inv[8] = {1.0f, 0.1939227432012558f, 0.03760603070259094f, 0.007292664609849453f, 0.0014142135623842478f, 0.00027424818836152554f, 5.318296098266728e-05f, 1.0313386155758053e-05f};
                float iv = inv[0];
#pragma unroll
                for (int q = 1; q < 8; ++q) iv = (lane == q) ? inv[q] : iv;
                const int pos = row < LP ? row : (row < MR ? 8192 + ((row - LP) & 3) : 0);
                const float ang = (float)pos * iv;
                double rev = (double)ang * 0.15915494309189535; rev -= __builtin_floor(rev);
                const float fr = (float)rev;
                sm[SM_ROPE + (size_t)row * 16 + lane] = __builtin_amdgcn_cosf(fr);
                sm[SM_ROPE + (size_t)row * 16 + 8 + lane] = __builtin_amdgcn_sinf(fr);
            }
        }
    }
    { unsigned* fl = (unsigned*)(sm + SM_FLAGS); for (int i = gtid; i < 8192 + 64; i += gthreads) fl[i] = 0u; }
    { u32x4* z = (u32x4*)(p.ws + WS_MIX + ((size_t)(MR >> 7) * (DM / 64) << 14)); const int n16 = (MPAD / 128 - (MR >> 7)) * (DM / 64) * 16384 / 16; for (int i = gtid; i < n16; i += gthreads) z[i] = (u32x4){0u, 0u, 0u, 0u}; }
    { u32x4* z = (u32x4*)(p.ws + WS_H1B + ((size_t)64 * (DM / 64) << 14)); const int n16 = 2 * (DM / 64) * 16384 / 16; for (int i = gtid; i < n16; i += gthreads) z[i] = (u32x4){0u, 0u, 0u, 0u}; }
    {
        const float* ck = p.in[2]; bf16_t* Ks = (bf16_t*)(p.ws + WS_KS);
        for (int i = gtid; i < 128 * 128 * 32; i += gthreads) {
            const int c8 = i & 31, u = (i >> 5) & 127, s = i >> 12;
            const float* src = ck + ((size_t)s * 128 + u) * 256 + c8 * 8;
            const f32x4 a = *(const f32x4*)src, b = *(const f32x4*)(src + 4);
            u32x4 w; w.x = cvt_pk_bf16(a[0], a[1]); w.y = cvt_pk_bf16(a[2], a[3]); w.z = cvt_pk_bf16(b[0], b[1]); w.w = cvt_pk_bf16(b[2], b[3]);
            *(u32x4*)(Ks + ((size_t)s * 132 + u) * 256 + c8 * 8) = w;
            if (u >= 4) { float* o = p.out + OFF_NKS + ((size_t)s * 128 + (u - 4)) * 256 + c8 * 8; *(f32x4*)o = a; *(f32x4*)(o + 4) = b; }
        }
    }
    {
        const float* cv = p.in[3]; bf16_t* Vts = (bf16_t*)(p.ws + WS_VTS);
        for (int i = gtid; i < 128 * 32 * 256; i += gthreads) {
            const int c = i & 255, uq = (i >> 8) & 31, s = i >> 13;
            const float* src = cv + ((size_t)s * 128 + 4 * uq) * 256 + c;
            u32x2 w; w.x = cvt_pk_bf16(src[0], src[256]); w.y = cvt_pk_bf16(src[512], src[768]);
            *(u32x2*)(Vts + ((size_t)s * 256 + c) * 136 + 4 * uq) = w;
        }
        for (int i = gtid; i < 128 * 124 * 64; i += gthreads) {
            const int c4 = i & 63, r = (i >> 6) % 124, s = (i >> 6) / 124;
            *(f32x4*)(p.out + OFF_NVS + ((size_t)s * 128 + r) * 256 + c4 * 4) = *(const f32x4*)(cv + ((size_t)s * 128 + r + 4) * 256 + c4 * 4);
        }
    }
    {
        LAS unsigned* T = (LAS unsigned*)lds;
        int id = blockIdx.x;
        f32x4 cur[8], n1[8], n2[8];
        const int G = gridDim.x;
        TileJob jc = decode_tile(p, id < N_WTILES ? id : 0), j1 = decode_tile(p, id + G < N_WTILES ? id + G : 0);
        if (id < N_WTILES) tile_load(jc, tid, cur);
        if (id + G < N_WTILES) tile_load(j1, tid, n1);
        while (id < N_WTILES) {
            const int id2 = id + 2 * G;
            TileJob j2 = decode_tile(p, id2 < N_WTILES ? id2 : 0);
            if (id2 < N_WTILES) tile_load(j2, tid, n2);
            tile_store(jc, tid, cur, T);
#pragma unroll
            for (int q = 0; q < 8; ++q) { cur[q] = n1[q]; n1[q] = n2[q]; }
            jc = j1; j1 = j2; id += G;
        }
    }
}

__device__ __forceinline__ void attn_item(const Params& p, int grp, int lane) {
    const int fr = lane & 15, fq = lane >> 4;
    const bf16_t* Qb = (const bf16_t*)(p.ws + WS_QB);
    bf16_t* Mix = (bf16_t*)(p.ws + WS_MIX);
    const bf16_t* Kb; const bf16_t* Vt; int vstride, qpos0, R0;
    if (grp < LP / 2) { Kb = (const bf16_t*)(p.ws + WS_KP); Vt = (const bf16_t*)(p.ws + WS_VTP); vstride = LP; qpos0 = grp * 2; R0 = grp * 2; }
    else { const int sg = grp - LP / 2, s = sg >> 1, hf = sg & 1; Kb = (const bf16_t*)(p.ws + WS_KS) + (size_t)s * 132 * 256; Vt = (const bf16_t*)(p.ws + WS_VTS) + (size_t)s * 256 * 136; vstride = 136;
        qpos0 = 128 + 2 * hf; R0 = LP + 4 * s + 2 * hf; }
    const int kstart = (qpos0 & ~3) - 156;
    const int tok = fr >> 3, g = fr & 7, qidx = qpos0 + tok;
    f32x4 O[4][4];
    float ssq = 0.f;
#pragma unroll
    for (int kvh = 0; kvh < 4; ++kvh) {
        bf16x8 qf[2];
        { const bf16_t* qp = Qb + (size_t)(R0 + tok) * QW + (kvh * 8 + g) * 64 + fq * 8; qf[0] = *(const bf16x8*)qp; qf[1] = *(const bf16x8*)(qp + 32); }
        f32x4 S[10];
#pragma unroll
        for (int kt = 0; kt < 10; ++kt) {
            int key = kstart + kt * 16 + fr; key = key < 0 ? 0 : key;
            const bf16_t* kp = Kb + (size_t)key * 256 + kvh * 64 + fq * 8;
            const bf16x8 k0 = *(const bf16x8*)kp, k1 = *(const bf16x8*)(kp + 32);
            f32x4 a = {0.f, 0.f, 0.f, 0.f};
            a = __builtin_amdgcn_mfma_f32_16x16x32_bf16(k0, qf[0], a, 0, 0, 0);
            a = __builtin_amdgcn_mfma_f32_16x16x32_bf16(k1, qf[1], a, 0, 0, 0);
            S[kt] = a;
        }
        const float sink = p.in[9][kvh * 8 + g];
        float mx = sink;
#pragma unroll
        for (int kt = 0; kt < 10; ++kt)
#pragma unroll
            for (int i = 0; i < 4; ++i) {
                const int kidx = kstart + kt * 16 + fq * 4 + i;
                const bool valid = (kidx >= 0) && (kidx <= qidx) && (kidx > qidx - 128);
                const float sv = valid ? S[kt][i] * 0.125f : -1e30f;
                S[kt][i] = sv; mx = fmaxf(mx, sv);
            }
        mx = fmaxf(mx, __shfl_xor(mx, 16)); mx = fmaxf(mx, __shfl_xor(mx, 32));
        float sum = 0.f;
#pragma unroll
        for (int kt = 0; kt < 10; ++kt)
#pragma unroll
            for (int i = 0; i < 4; ++i) { const float e = __expf(S[kt][i] - mx); S[kt][i] = e; sum += e; }
        sum += __shfl_xor(sum, 16); sum += __shfl_xor(sum, 32);
        sum += __expf(sink - mx);
        const float inv = 1.0f / sum;
#pragma unroll
        for (int dt = 0; dt < 4; ++dt) O[kvh][dt] = (f32x4){0.f, 0.f, 0.f, 0.f};
#pragma unroll
        for (int ks = 0; ks < 5; ++ks) {
            u32x4 pw; pw.x = cvt_pk_bf16(S[2 * ks][0], S[2 * ks][1]); pw.y = cvt_pk_bf16(S[2 * ks][2], S[2 * ks][3]);
            pw.z = cvt_pk_bf16(S[2 * ks + 1][0], S[2 * ks + 1][1]); pw.w = cvt_pk_bf16(S[2 * ks + 1][2], S[2 * ks + 1][3]);
            const bf16x8 pf = __builtin_bit_cast(bf16x8, pw);
            int kg0 = kstart + ks * 32 + fq * 4, kg1 = kg0 + 16;
            kg0 = kg0 < 0 ? 0 : kg0; kg1 = kg1 < 0 ? 0 : kg1;
#pragma unroll
            for (int dt = 0; dt < 4; ++dt) {
                const bf16_t* vrow = Vt + (size_t)(kvh * 64 + dt * 16 + fr) * vstride;
                const u32x2 lo = *(const u32x2*)(vrow + kg0), hi = *(const u32x2*)(vrow + kg1);
                u32x4 w; w.x = lo.x; w.y = lo.y; w.z = hi.x; w.w = hi.y;
                O[kvh][dt] = __builtin_amdgcn_mfma_f32_16x16x32_bf16(__builtin_bit_cast(bf16x8, w), pf, O[kvh][dt], 0, 0, 0);
            }
        }
#pragma unroll
        for (int dt = 0; dt < 4; ++dt) { O[kvh][dt] *= inv; const f32x4 o = O[kvh][dt]; ssq += (o[0] * o[0] + o[1] * o[1]) + (o[2] * o[2] + o[3] * o[3]); }
    }
    ssq += __shfl_xor(ssq, 16); ssq += __shfl_xor(ssq, 32); ssq += __shfl_xor(ssq, 1); ssq += __shfl_xor(ssq, 2); ssq += __shfl_xor(ssq, 4);
    const float rs = __builtin_amdgcn_rsqf(ssq * (1.0f / 2048.0f) + EPS);
#pragma unroll
    for (int kvh = 0; kvh < 4; ++kvh) {
#pragma unroll
        for (int dt = 0; dt < 4; ++dt) {
            const f32x4 o = O[kvh][dt] * rs;
            u32x2 w; w.x = cvt_pk_bf16(o[0], o[1]); w.y = cvt_pk_bf16(o[2], o[3]);
            *(u32x2*)((char*)Mix + tiled_off(R0 + tok, (kvh * 8 + g) * 64 + dt * 16 + fq * 4, DM / 64)) = w;
        }
    }
}

__device__ __forceinline__ void conv_row(const Params& p, int row, int lane) {
    const bf16_t* Ub = (const bf16_t*)(p.ws + WS_UB); const bf16_t* CBb = (const bf16_t*)(p.ws + WS_CBB);
    bf16_t* Mix = (bf16_t*)(p.ws + WS_MIX);
    const float* cw = p.in[10];
    const bool samp = row >= LP; const int sr = row - LP, s = sr >> 2, t = sr & 3;
    float ss = 0.f;
    float o[4][8];
#pragma unroll
    for (int it = 0; it < 4; ++it) {
        const int col = it * 512 + lane * 8;
        float u0[8], u1[8], u2[8], cb[8], w0[8], w1[8], w2[8];
        unpack8(*(const u32x4*)(Ub + (size_t)row * CWID + col), u2);
        unpack8(*(const u32x4*)(CBb + (size_t)row * CWID + col), cb);
        const bool has1 = samp ? (t >= 1) : (row >= 1), has2 = samp ? (t >= 2) : (row >= 2);
        if (has1) unpack8(*(const u32x4*)(Ub + (size_t)(row - 1) * CWID + col), u1);
        else if (samp) load8f(p.in[4] + ((size_t)s * 2 + 1) * CWID + col, u1);
        else {
#pragma unroll
            for (int q = 0; q < 8; ++q) u1[q] = 0.f; }
        if (has2) unpack8(*(const u32x4*)(Ub + (size_t)(row - 2) * CWID + col), u0);
        else if (samp) load8f(p.in[4] + ((size_t)s * 2 + t) * CWID + col, u0);
        else {
#pragma unroll
            for (int q = 0; q < 8; ++q) u0[q] = 0.f; }
        load8f(cw + col, w0); load8f(cw + CWID + col, w1); load8f(cw + 2 * CWID + col, w2);
#pragma unroll
        for (int q = 0; q < 8; ++q) { o[it][q] = cb[q] * (u0[q] * w0[q] + u1[q] * w1[q] + u2[q] * w2[q]); ss += o[it][q] * o[it][q]; }
    }
    ss = wave_sum(ss);
    const float rs = __builtin_amdgcn_rsqf(ss * (1.0f / 2048.0f) + EPS);
#pragma unroll
    for (int it = 0; it < 4; ++it) {
        const int col = it * 512 + lane * 8;
        u32x4 w; w.x = cvt_pk_bf16(o[it][0] * rs, o[it][1] * rs); w.y = cvt_pk_bf16(o[it][2] * rs, o[it][3] * rs); w.z = cvt_pk_bf16(o[it][4] * rs, o[it][5] * rs); w.w = cvt_pk_bf16(o[it][6] * rs, o[it][7] * rs);
        *(u32x4*)((char*)Mix + tiled_off(row, 2048 + col, DM / 64)) = w;
    }
}

__device__ __forceinline__ void phase2(const Params& p, int wv) {
    int tid = my_tid(wv); asm volatile("" : "+v"(tid));
    const int lane = tid & 63, wid = __builtin_amdgcn_readfirstlane(tid >> 6);
    const int gwaves = gridDim.x * 8, gwave = (((int)blockIdx.x & 7) * ((int)gridDim.x >> 3) + ((int)blockIdx.x >> 3)) * 8 + wid;
    constexpr int NGRP = LP / 2 + 256;
    for (int it = gwave; it < NGRP; it += gwaves) attn_item(p, it, lane);
    const int heavy = (NGRP > 2 * gwaves && NGRP < 3 * gwaves) ? NGRP - 2 * gwaves : 0;
    if (gwave >= heavy) for (int row = gwave - heavy; row < MR; row += gwaves - heavy) conv_row(p, row, lane);
}

__device__ __forceinline__ void phase7(const Params& p, int wv) {
    int tid = my_tid(wv); asm volatile("" : "+v"(tid));
    const int lane = tid & 63, wid = tid >> 6;
    const int gwaves = gridDim.x * 8, gwave = blockIdx.x * 8 + wid;
    const float* sm = (const float*)(p.ws + WS_SM); const float* gf = p.in[18];
    for (int row = 16 + gwave; row < MR; row += gwaves) {
        float* o = row < LP ? p.out + OFF_YP + (size_t)(row - 16) * DM : p.out + OFF_YS + (size_t)(row - LP) * DM;
        const bf16_t* h = (const bf16_t*)(p.ws + WS_H2B) + (size_t)row * DM;
        const float rs = __builtin_amdgcn_rsqf(sm[SM_RSQ2 + row] * (1.0f / 4096.0f) + EPS);
#pragma unroll 4
        for (int it = 0; it < 8; ++it) {
            const int c = it * 512 + lane * 8;
            const u32x4 w = *(const u32x4*)(h + c);
            const f32x4 g0 = *(const f32x4*)(gf + c), g1 = *(const f32x4*)(gf + c + 4);
            *(f32x4*)(o + c) = (f32x4){bf_lo(w.x), bf_hi(w.x), bf_lo(w.y), bf_hi(w.y)} * rs * g0;
            *(f32x4*)(o + c + 4) = (f32x4){bf_lo(w.z), bf_hi(w.z), bf_lo(w.w), bf_hi(w.w)} * rs * g1;
        }
    }
}

__device__ __forceinline__ void grid_barrier(unsigned* ctr, unsigned target, int wv) {
    asm volatile("s_waitcnt vmcnt(0)" ::: "memory");
    __syncthreads();
    if (my_tid(wv) == 0) {
        __builtin_amdgcn_fence(__ATOMIC_RELEASE, "agent");
        asm volatile("s_waitcnt vmcnt(0)" ::: "memory");
        __hip_atomic_fetch_add(ctr, 1u, __ATOMIC_RELAXED, __HIP_MEMORY_SCOPE_AGENT);
        while (__hip_atomic_load(ctr, __ATOMIC_RELAXED, __HIP_MEMORY_SCOPE_AGENT) < target) __builtin_amdgcn_s_sleep(2);
        __builtin_amdgcn_fence(__ATOMIC_ACQUIRE, "agent");
        asm volatile("s_waitcnt vmcnt(0)" ::: "memory");
    }
    __syncthreads();
}

__device__ __forceinline__ Params load_params() {
#if defined(__HIP_DEVICE_COMPILE__)
    typedef const __attribute__((address_space(4))) Params* KParams;
    KParams k = (KParams)__builtin_amdgcn_kernarg_segment_ptr(); asm volatile("" : "+s"(k));
    Params r;
#pragma unroll
    for (int i = 0; i < 19; ++i) r.in[i] = k->in[i];
    r.out = k->out; r.ws = k->ws; return r;
#else
    return Params{};
#endif
}

__global__ void __launch_bounds__(512, 2) fwd_megakernel(Params p_unused) {
    extern __shared__ __attribute__((aligned(16))) unsigned char lds_raw[];
    LAS unsigned char* lds = (LAS unsigned char*)lds_raw;
    cg::grid_group grid = cg::this_grid();
    const int wv = __builtin_amdgcn_readfirstlane((int)threadIdx.x >> 6);
#define PHASE_PTRS const Params p = load_params(); float* sm = (float*)(p.ws + WS_SM); unsigned* flags = (unsigned*)(sm + SM_FLAGS); unsigned* gbar = flags + 8192 + 32; f32x4* part = (f32x4*)(p.ws + WS_PART); (void)gbar; (void)flags; (void)part

    { PHASE_PTRS; phase0(p, lds, wv); }
    grid.sync();
    {
        PHASE_PTRS;
        pg8::Gemm g{(const bf16_t*)(p.ws + WS_A1), (const bf16_t*)(p.ws + WS_W1), MPAD, INW, DM};
        pg8::StaticOrder S; S.init(MPAD, INW, DM, blockIdx.x, 0);
        EpiIn E{sm, (bf16_t*)(p.ws + WS_QB), (bf16_t*)(p.ws + WS_KP), (bf16_t*)(p.ws + WS_KS), (bf16_t*)(p.ws + WS_VTP), (bf16_t*)(p.ws + WS_VTS), (bf16_t*)(p.ws + WS_CBB), (bf16_t*)(p.ws + WS_UB), p.out};
        pg8::gemm_phase(lds, g, S, E, wv, part, flags);
        grid_barrier(gbar, 1u * gridDim.x, wv);
    }
    { PHASE_PTRS; phase2(p, wv); grid_barrier(gbar, 2u * gridDim.x, wv); }
    {
        PHASE_PTRS;
        pg8::Gemm g{(const bf16_t*)(p.ws + WS_MIX), (const bf16_t*)(p.ws + WS_W2), MPAD, DM, DM};
        pg8::StaticOrder S; S.init(MPAD, DM, DM, blockIdx.x, 1);
        EpiOut E{sm, p.in[0], p.in[1], p.in[6], (bf16_t*)(p.ws + WS_H1B)};
        pg8::gemm_phase(lds, g, S, E, wv, part, flags);
        grid_barrier(gbar, 3u * gridDim.x, wv);
    }
    {
        PHASE_PTRS;
        pg8::Gemm g{(const bf16_t*)(p.ws + WS_H1B), (const bf16_t*)(p.ws + WS_W3), MPAD, 2 * DFF, DM};
        pg8::StaticOrder S; S.init(MPAD, 2 * DFF, DM, blockIdx.x, 0);
        EpiGU E{sm, (bf16_t*)(p.ws + WS_ACT), p.out, p.in[16], p.in[5], (LAS float*)(lds + pg8::STAGE_BYTES), lds + pg8::STAGE_BYTES + 3072};
        pg8::gemm_phase(lds, g, S, E, wv, part, flags);
        grid_barrier(gbar, 4u * gridDim.x, wv);
    }
    {
        PHASE_PTRS;
        pg8::Gemm g{(const bf16_t*)(p.ws + WS_ACT), (const bf16_t*)(p.ws + WS_W4), MPAD, DM, DFF};
        pg8::StaticOrder S; S.init(MPAD, DM, DFF, blockIdx.x, 1);
        EpiDown E{sm, (const bf16_t*)(p.ws + WS_H1B), (bf16_t*)(p.ws + WS_H2B)};
        pg8::gemm_phase(lds, g, S, E, wv, part, flags + 2048);
        grid_barrier(gbar, 5u * gridDim.x, wv);
    }
    { PHASE_PTRS; phase7(p, wv); }
#undef PHASE_PTRS
}

extern "C" void kernel_launch(void* const* d_in, const int* in_sizes, int n_in, void* d_out, int out_size, void* d_ws, size_t ws_size, hipStream_t stream) {
    constexpr int LDS_BYTES = pg8::STAGE_BYTES + 8192;
    static int grid = 0;
    if (grid == 0) {
        if (n_in != 19 || (size_t)out_size != OUT_TOTAL || ws_size < WS_END) { fprintf(stderr, "kernel_launch: unexpected shapes (n_in %d out %d ws %zu need %zu)\n", n_in, out_size, ws_size, (size_t)WS_END); grid = -1; return; }
        int dev = 0, cus = 0, per_cu = 0;
        (void)hipGetDevice(&dev);
        (void)hipDeviceGetAttribute(&cus, hipDeviceAttributeMultiprocessorCount, dev);
        if (hipFuncSetAttribute((const void*)fwd_megakernel, hipFuncAttributeMaxDynamicSharedMemorySize, LDS_BYTES) != hipSuccess) { fprintf(stderr, "kernel_launch: hipFuncSetAttribute failed\n"); grid = -1; return; }
        (void)hipOccupancyMaxActiveBlocksPerMultiprocessor(&per_cu, (const void*)fwd_megakernel, 512, LDS_BYTES);
        if (per_cu < 1) per_cu = 1;
        (void)hipGetLastError();
        grid = cus;
        if (grid != 256) { fprintf(stderr, "kernel_launch: built for 256 CUs, found %d\n", cus); grid = -1; return; }
        fprintf(stderr, "kernel_launch: cus %d per_cu %d grid %d\n", cus, per_cu, grid);
    }
    if (grid < 0) return;
    Params p{};
    for (int i = 0; i < 19; ++i) p.in[i] = (const float*)d_in[i];
    p.out = (float*)d_out; p.ws = (unsigned char*)d_ws;
    void* args[] = {&p};
    hipError_t e = hipLaunchCooperativeKernel((const void*)fwd_megakernel, dim3(grid), dim3(512), args, LDS_BYTES, stream);
    if (e != hipSuccess) fprintf(stderr, "cooperative launch failed: %s (grid %d)\n", hipGetErrorString(e), grid);
}
```
